# Optimizing an MI355X kernel written in HIP

```python
import math
import jax, jax.numpy as jnp
from jax import lax
import numpy as np

D_MODEL = 2048
BATCH = 8
SEQ = 4096
DEPTH = 1

CHUNK = 64
Q_BLOCK = 128
HEAD_DIM = 128
N_HEADS_DIFF = D_MODEL // (2 * HEAD_DIM)
DIFF_QK_DIM = HEAD_DIM // 2
N_HEADS_SB = D_MODEL // (2 * HEAD_DIM)
DIFF_WIDTH = N_HEADS_DIFF * HEAD_DIM
SB_WIDTH = N_HEADS_SB * HEAD_DIM
MIX_WIDTH = DIFF_WIDTH + SB_WIDTH
IN_COLS = 3 * DIFF_WIDTH + 3 * SB_WIDTH
N_MEM = 256
N_HEADS_MEM = 4
MEM_HEAD_DIM = D_MODEL // N_HEADS_MEM
D_FF = ((8 * D_MODEL // 3 + 255) // 256) * 256
N_BUCKETS = 32
MAX_DISTANCE = 128
EPS = 1e-6

kernel_name = "hybrid_diff_stickbreak_chunk_encoder"


def rms_norm(x, g):
    xf = x.astype(jnp.float32)
    y = xf * lax.rsqrt(jnp.mean(xf * xf, axis=-1, keepdims=True) + EPS)
    return (y * g.astype(jnp.float32)).astype(x.dtype)


def lambda_init(layer_idx):
    return 0.8 - 0.6 * math.exp(-0.3 * layer_idx)


def t5_bucket(rel):
    nb = N_BUCKETS // 2
    ret = jnp.where(rel > 0, nb, 0)
    n = jnp.abs(rel)
    max_exact = nb // 2
    nf = jnp.maximum(n, 1).astype(jnp.float32)
    large = max_exact + (jnp.log(nf / max_exact) / math.log(MAX_DISTANCE / max_exact)
                         * (nb - max_exact)).astype(jnp.int32)
    large = jnp.minimum(large, nb - 1)
    return ret + jnp.where(n < max_exact, n, large)


def to_blocks(q):
    b, s, h, d = q.shape
    return q.reshape(b, s // Q_BLOCK, Q_BLOCK, h, d).transpose(1, 0, 2, 3, 4)


def from_blocks(o):
    nb, b, qb, h, d = o.shape
    return o.transpose(1, 0, 2, 3, 4).reshape(b, nb * qb, h, d)


def diff_attention(q, k, v, bias_table, lam, sub_gain, lam_init):
    seq = q.shape[1]
    key_pos = jnp.arange(seq, dtype=jnp.int32)
    k1, k2 = k[..., :DIFF_QK_DIM], k[..., DIFF_QK_DIM:]
    scale = DIFF_QK_DIM ** -0.5

    def block(args):
        i, qi = args
        q_pos = i * Q_BLOCK + jnp.arange(Q_BLOCK, dtype=jnp.int32)
        allowed = (key_pos[None, :] // CHUNK) <= (q_pos[:, None] // CHUNK)
        bias = bias_table[t5_bucket(key_pos[None, :] - q_pos[:, None])]
        bias = jnp.transpose(bias, (2, 0, 1)).astype(jnp.float32)[None]

        def softmax_map(qh, kh):
            s = jnp.einsum('bqhd,bkhd->bhqk', qh, kh).astype(jnp.float32) * scale + bias
            s = jnp.where(allowed, s, -jnp.inf)
            return jax.nn.softmax(s, axis=-1)

        p = softmax_map(qi[..., :DIFF_QK_DIM], k1) - lam * softmax_map(qi[..., DIFF_QK_DIM:], k2)
        return jnp.einsum('bhqk,bkhd->bqhd', p.astype(v.dtype), v)

    nb = seq // Q_BLOCK
    out = from_blocks(lax.map(block, (jnp.arange(nb, dtype=jnp.int32), to_blocks(q))))
    out = rms_norm(out, sub_gain) * (1.0 - lam_init)
    return out.reshape(out.shape[0], seq, -1)


def stick_breaking(q, k, v, out_gain):
    seq = q.shape[1]
    key_pos = jnp.arange(seq, dtype=jnp.int32)
    scale = HEAD_DIM ** -0.5

    def block(args):
        i, qi = args
        q_pos = i * Q_BLOCK + jnp.arange(Q_BLOCK, dtype=jnp.int32)
        strict = key_pos[None, :] < q_pos[:, None]
        z = jnp.einsum('bqhd,bkhd->bhqk', qi, k).astype(jnp.float32) * scale
        log_beta = jax.nn.log_sigmoid(z)
        log_keep = jnp.where(strict, jax.nn.log_sigmoid(-z), 0.0)
        after = lax.cumsum(log_keep, axis=log_keep.ndim - 1, reverse=True) - log_keep
        w = jnp.where(strict, jnp.exp(log_beta + after), 0.0)
        return jnp.einsum('bhqk,bkhd->bqhd', w.astype(v.dtype), v)

    nb = seq // Q_BLOCK
    out = from_blocks(lax.map(block, (jnp.arange(nb, dtype=jnp.int32), to_blocks(q))))
    out = rms_norm(out, out_gain)
    return out.reshape(out.shape[0], seq, -1)


def memory_attention(h, mem_n, w_q, w_kv, w_o):
    b, s, _ = h.shape
    q = (h @ w_q).reshape(b, s, N_HEADS_MEM, MEM_HEAD_DIM)
    kv = mem_n @ w_kv
    k = kv[..., :D_MODEL].reshape(b, N_MEM, N_HEADS_MEM, MEM_HEAD_DIM)
    v = kv[..., D_MODEL:].reshape(b, N_MEM, N_HEADS_MEM, MEM_HEAD_DIM)
    s_ = jnp.einsum('bqhd,bmhd->bhqm', q, k).astype(jnp.float32) * (MEM_HEAD_DIM ** -0.5)
    p = jax.nn.softmax(s_, axis=-1).astype(v.dtype)
    o = jnp.einsum('bhqm,bmhd->bqhd', p, v).reshape(b, s, D_MODEL)
    return o @ w_o


def setup_inputs(seed: int = 0) -> dict:
    key = jax.random.key(seed)
    ks = jax.random.split(key, 24)
    f32 = jnp.float32

    def w(k, shape, fan_in):
        return jax.random.normal(k, shape, f32) * (fan_in ** -0.5)

    def gain(k, shape):
        return 1.0 + 0.05 * jax.random.normal(k, shape, f32)

    return {
        "x": jax.random.normal(ks[0], (BATCH, SEQ, D_MODEL), f32),
        "mem": jax.random.normal(ks[1], (BATCH, N_MEM, D_MODEL), f32),
        "w_in": w(ks[2], (DEPTH, D_MODEL, IN_COLS), D_MODEL),
        "w_out": w(ks[3], (DEPTH, MIX_WIDTH, D_MODEL), MIX_WIDTH),
        "rel_bias": 0.5 * jax.random.normal(ks[4], (N_BUCKETS, N_HEADS_DIFF), f32),
        "lambda_q1": 0.1 * jax.random.normal(ks[5], (DEPTH, DIFF_QK_DIM), f32),
        "lambda_k1": 0.1 * jax.random.normal(ks[6], (DEPTH, DIFF_QK_DIM), f32),
        "lambda_q2": 0.1 * jax.random.normal(ks[7], (DEPTH, DIFF_QK_DIM), f32),
        "lambda_k2": 0.1 * jax.random.normal(ks[8], (DEPTH, DIFF_QK_DIM), f32),
        "diff_sub_gain": gain(ks[9], (DEPTH, HEAD_DIM)),
        "sb_gain": gain(ks[10], (DEPTH, HEAD_DIM)),
        "g_mix_pre": gain(ks[11], (DEPTH, D_MODEL)),
        "g_mix_post": gain(ks[12], (DEPTH, D_MODEL)),
        "w_mq": w(ks[13], (DEPTH, D_MODEL, D_MODEL), D_MODEL),
        "w_mkv": w(ks[14], (DEPTH, D_MODEL, 2 * D_MODEL), D_MODEL),
        "w_mo": w(ks[15], (DEPTH, D_MODEL, D_MODEL), D_MODEL),
        "g_mem_kv": gain(ks[16], (DEPTH, D_MODEL)),
        "g_mem_pre": gain(ks[17], (DEPTH, D_MODEL)),
        "g_mem_post": gain(ks[18], (DEPTH, D_MODEL)),
        "w_gate_up": w(ks[19], (DEPTH, D_MODEL, 2 * D_FF), D_MODEL),
        "w_down": w(ks[20], (DEPTH, D_FF, D_MODEL), D_FF),
        "g_ffn_pre": gain(ks[21], (DEPTH, D_MODEL)),
        "g_ffn_post": gain(ks[22], (DEPTH, D_MODEL)),
    }


def reference(x, mem, w_in, w_out, rel_bias, lambda_q1, lambda_k1, lambda_q2, lambda_k2,
              diff_sub_gain, sb_gain, g_mix_pre, g_mix_post, w_mq, w_mkv, w_mo,
              g_mem_kv, g_mem_pre, g_mem_post, w_gate_up, w_down, g_ffn_pre, g_ffn_post):
    b, s, _ = x.shape
    for l in range(DEPTH):
        lam_init = lambda_init(l)
        h = rms_norm(x, g_mix_pre[l])
        proj = h @ w_in[l]
        a_q, a_k, a_v, b_q, b_k, b_v = jnp.split(
            proj, [DIFF_WIDTH, 2 * DIFF_WIDTH, 3 * DIFF_WIDTH,
                   3 * DIFF_WIDTH + SB_WIDTH, 3 * DIFF_WIDTH + 2 * SB_WIDTH], axis=-1)
        a_q = a_q.reshape(b, s, N_HEADS_DIFF, HEAD_DIM)
        a_k = a_k.reshape(b, s, N_HEADS_DIFF, HEAD_DIM)
        a_v = a_v.reshape(b, s, N_HEADS_DIFF, HEAD_DIM)
        b_q = b_q.reshape(b, s, N_HEADS_SB, HEAD_DIM)
        b_k = b_k.reshape(b, s, N_HEADS_SB, HEAD_DIM)
        b_v = b_v.reshape(b, s, N_HEADS_SB, HEAD_DIM)
        lam = (jnp.exp(jnp.sum(lambda_q1[l].astype(jnp.float32) * lambda_k1[l].astype(jnp.float32)))
               - jnp.exp(jnp.sum(lambda_q2[l].astype(jnp.float32) * lambda_k2[l].astype(jnp.float32)))
               + lam_init)
        out_a = diff_attention(a_q, a_k, a_v, rel_bias, lam, diff_sub_gain[l], lam_init)
        out_b = stick_breaking(b_q, b_k, b_v, sb_gain[l])
        mix = jnp.concatenate([out_a, out_b], axis=-1) @ w_out[l]
        x = x + rms_norm(mix, g_mix_post[l])
        h = rms_norm(x, g_mem_pre[l])
        mem_n = rms_norm(mem, g_mem_kv[l])
        o = memory_attention(h, mem_n, w_mq[l], w_mkv[l], w_mo[l])
        x = x + rms_norm(o, g_mem_post[l])
        h = rms_norm(x, g_ffn_pre[l])
        gu = h @ w_gate_up[l]
        f = (jax.nn.silu(gu[..., :D_FF]) * gu[..., D_FF:]) @ w_down[l]
        x = x + rms_norm(f, g_ffn_post[l])
    return x
```

```cpp
#define GSYNC() xcd_barrier(xbar)
#include <hip/hip_runtime.h>
#include <hip/hip_cooperative_groups.h>
#include <cstdint>
#include <cstdio>
namespace cg = cooperative_groups;

#define LAS __attribute__((address_space(3)))
typedef unsigned short bf16_t;
typedef short bf16x8 __attribute__((ext_vector_type(8)));
typedef float f32x4 __attribute__((ext_vector_type(4)));
typedef float f32x16 __attribute__((ext_vector_type(16)));
typedef unsigned u32x4 __attribute__((ext_vector_type(4)));
typedef unsigned u32x2 __attribute__((ext_vector_type(2)));
typedef float f32x2_t __attribute__((ext_vector_type(2)));
typedef __bf16 bf16x2_t __attribute__((ext_vector_type(2)));

constexpr int NB = 8, SEQ = 4096, DM = 2048, MT = NB * SEQ, DFF = 5632;
constexpr float LOG2E = 1.4426950408889634f;
constexpr float EPS = 1e-6f;
constexpr size_t MiB = 1u << 20;
constexpr size_t WS_WQK = 2 * MiB, WS_WV = 18 * MiB, WS_WOUT = 26 * MiB, WS_WMQ = 34 * MiB, WS_WMKV = 42 * MiB, WS_WMO = 58 * MiB,
                 WS_WGU = 66 * MiB, WS_WDN = 110 * MiB, WS_MEMN = 132 * MiB, WS_KVM = 140 * MiB, WS_WKT = 156 * MiB, WS_VWT = 188 * MiB,
                 WS_H = 224 * MiB, WS_QK = 352 * MiB, WS_VT = 608 * MiB, WS_AO = 736 * MiB, WS_MIX = 352 * MiB, WS_S = 480 * MiB,
                 WS_P = 608 * MiB, WS_MEMO = 672 * MiB, WS_F = 352 * MiB, WS_FO = 704 * MiB, WS_KD = 864 * MiB, WS_KS = 928 * MiB, WS_XR = 864 * MiB  , WS_PARK = 992 * MiB, WS_END = 1008 * MiB;

struct Params {
    const float* x; const float* mem; const float* w_in; const float* w_out; const float* rel_bias;
    const float* lq1; const float* lk1; const float* lq2; const float* lk2;
    const float* diff_gain; const float* sb_gain; const float* g_mix_pre; const float* g_mix_post;
    const float* w_mq; const float* w_mkv; const float* w_mo; const float* g_mem_kv; const float* g_mem_pre; const float* g_mem_post;
    const float* w_gu; const float* w_down; const float* g_ffn_pre; const float* g_ffn_post;
    float* out; unsigned char* ws;
};

__device__ __forceinline__ unsigned cvtpk(float lo, float hi) { f32x2_t v = {lo, hi}; bf16x2_t b = __builtin_convertvector(v, bf16x2_t); return __builtin_bit_cast(unsigned, b); }
__device__ __forceinline__ float bf_lo(unsigned u) { return __uint_as_float(u << 16); }
__device__ __forceinline__ float bf_hi(unsigned u) { return __uint_as_float(u & 0xffff0000u); }
__device__ __forceinline__ float wave_sum(float v) {
#pragma unroll
    for (int o = 1; o < 64; o <<= 1) v += __shfl_xor(v, o);
    return v;
}
__device__ __forceinline__ float wave_max(float v) {
#pragma unroll
    for (int o = 1; o < 64; o <<= 1) v = fmaxf(v, __shfl_xor(v, o));
    return v;
}
__device__ __forceinline__ float ex2(float v) { return __builtin_amdgcn_exp2f(v); }
__device__ __forceinline__ float lg2(float v) { return __builtin_amdgcn_logf(v); }

namespace pg8 {
constexpr int BM = 256, BK = 64, HALF = 128, HTB = HALF * BK * 2, STAGE_BYTES = 8 * HTB;
__device__ __forceinline__ int lds_byte(int r, int c) { const int st = (r >> 4) * 2 + (c >> 5), rr = r & 15, cc = c & 31, ob = rr * 64 + cc * 2; return st * 1024 + (ob ^ (((ob >> 9) & 1) << 5)); }
__device__ __forceinline__ void stage_rc(int b, int& R, int& C) { const int st = b / 1024, sb = b % 1024, swz = sb ^ (((sb >> 9) & 1) << 5); R = (st >> 1) * 16 + swz / 64; C = (st & 1) * 32 + (swz % 64) / 2; }
__device__ __forceinline__ int perm32(int rho) { const int n = rho >> 4, i = rho & 15; return 8 * (i >> 2) + 4 * n + (i & 3); }

struct GUnit { const char* A; const char* B; char* C; int SA, SR, SB, SX; float scale; };

struct GemmDesc {
    size_t A, B, C;
    int K, lda, ldb, ldc;
    int nM, nN;
    int kind, mode;
    int scale_kind;
    float scale;
    size_t a_tile, b_tile, b_batch, c_rt, c_ct;
    size_t a_b, a_h, a_t, b_b, b_h, b_t, c_b, c_h, c_t;
};

constexpr GemmDesc make_desc(int gi) {
    GemmDesc d{};
    d.scale = 1.0f; d.kind = 0; d.mode = 0; d.scale_kind = 0;
    switch (gi) {
    case 0:
        d.A = WS_H; d.B = WS_WQK; d.C = WS_QK;
        d.K = 2048; d.lda = 2048; d.ldb = 2048; d.ldc = 4096; d.nM = 128; d.nN = 16; d.scale_kind = 1;
        d.a_tile = (size_t)256 * 2048 * 2; d.b_tile = (size_t)256 * 2048 * 2; d.c_rt = (size_t)256 * 4096 * 2; d.c_ct = 512; break;
    case 1:
        d.A = WS_WV; d.B = WS_H; d.C = WS_VT;
        d.K = 2048; d.lda = 2048; d.ldb = 2048; d.ldc = MT; d.nM = 8; d.nN = 128; d.scale_kind = 2;
        d.a_tile = (size_t)256 * 2048 * 2; d.b_tile = (size_t)256 * 2048 * 2; d.c_rt = (size_t)256 * MT * 2; d.c_ct = 512; break;
    case 2:
        d.A = WS_MEMN; d.B = WS_WMKV; d.C = WS_KVM;
        d.K = 2048; d.lda = 2048; d.ldb = 2048; d.ldc = 4096; d.nM = 8; d.nN = 16;
        d.a_tile = (size_t)256 * 2048 * 2; d.b_tile = (size_t)256 * 2048 * 2; d.c_rt = (size_t)256 * 4096 * 2; d.c_ct = 512; break;
    case 3:
        d.A = WS_AO; d.B = WS_WOUT; d.C = WS_MIX;
        d.K = 2048; d.lda = 2048; d.ldb = 2048; d.ldc = 2048; d.nM = 128; d.nN = 8;
        d.a_tile = (size_t)256 * 2048 * 2; d.b_tile = (size_t)256 * 2048 * 2; d.c_rt = (size_t)256 * 2048 * 2; d.c_ct = 512; break;
    case 4:
        d.kind = 1; d.A = WS_KVM; d.B = WS_WMQ; d.C = WS_WKT;
        d.K = 512; d.lda = 4096; d.ldb = 2048; d.ldc = 2048; d.scale = 0.04419417382415922f * LOG2E;
        d.a_b = (size_t)256 * 4096 * 2; d.a_h = 1024; d.a_t = 0;
        d.b_b = 0; d.b_h = 1024; d.b_t = (size_t)256 * 2048 * 2;
        d.c_b = (size_t)1024 * 2048 * 2; d.c_h = (size_t)256 * 2048 * 2; d.c_t = 512; break;
    case 5:
        d.kind = 1; d.A = WS_WMO; d.B = WS_KVM + 4096; d.C = WS_VWT;
        d.K = 512; d.lda = 2048; d.ldb = 4096; d.ldc = 1024;
        d.a_b = 0; d.a_h = 1024; d.a_t = (size_t)256 * 2048 * 2;
        d.b_b = (size_t)256 * 4096 * 2; d.b_h = 1024; d.b_t = 0;
        d.c_b = (size_t)2048 * 1024 * 2; d.c_h = 512; d.c_t = (size_t)256 * 1024 * 2; break;
    case 6:
        d.A = WS_H; d.B = WS_WKT; d.C = WS_P; d.mode = 3;
        d.K = 2048; d.lda = 2048; d.ldb = 2048; d.ldc = 1024; d.nM = 128; d.nN = 4;
        d.a_tile = (size_t)256 * 2048 * 2; d.b_tile = (size_t)256 * 2048 * 2; d.b_batch = (size_t)1024 * 2048 * 2; d.c_rt = (size_t)256 * 1024 * 2; d.c_ct = 512; break;
    case 7:
        d.A = WS_P; d.B = WS_VWT; d.C = WS_MEMO;
        d.K = 1024; d.lda = 1024; d.ldb = 1024; d.ldc = 2048; d.nM = 128; d.nN = 8;
        d.a_tile = (size_t)256 * 1024 * 2; d.b_tile = (size_t)256 * 1024 * 2; d.b_batch = (size_t)2048 * 1024 * 2; d.c_rt = (size_t)256 * 2048 * 2; d.c_ct = 512; break;
    case 8:
        d.A = WS_H; d.B = WS_WGU; d.C = WS_F; d.mode = 2;
        d.K = 2048; d.lda = 2048; d.ldb = 2048; d.ldc = DFF; d.nM = 128; d.nN = 44;
        d.a_tile = (size_t)256 * 2048 * 2; d.b_tile = (size_t)256 * 2048 * 2; d.c_rt = (size_t)256 * DFF * 2; d.c_ct = 256; break;
    default:
        d.A = WS_F; d.B = WS_WDN; d.C = WS_FO;
        d.K = DFF; d.lda = DFF; d.ldb = DFF; d.ldc = 2048; d.nM = 128; d.nN = 8;
        d.a_tile = (size_t)256 * DFF * 2; d.b_tile = (size_t)256 * DFF * 2; d.c_rt = (size_t)256 * 2048 * 2; d.c_ct = 512; break;
    }
    return d;
}

template <int GI>
__device__ __forceinline__ bool sched_next(unsigned char* ws, int i, int G, int c, GUnit& u) {
    constexpr GemmDesc d = make_desc(GI);
    const int L = i * G + c;
    u.SA = 128 * d.ldc; u.SR = d.ldc; u.SB = 128; u.SX = 64; u.scale = d.scale;
    if (d.kind == 0) {
        constexpr int nwg = d.nM * d.nN;
        if (L >= nwg) return false;
        int wgid = L;
        { constexpr int q = nwg / 8, r = nwg % 8; const int xcd = wgid % 8, off = wgid / 8; wgid = (xcd < r ? xcd * (q + 1) : r * (q + 1) + (xcd - r) * q) + off; }
        constexpr int nig = 8 * d.nN; const int gid = wgid / nig, fm = gid * 8, gsz = (d.nM - fm) < 8 ? (d.nM - fm) : 8;
        const int pm = fm + ((wgid % nig) % gsz), pn = (wgid % nig) / gsz;
        u.A = (const char*)ws + d.A + (size_t)pm * d.a_tile;
        u.B = (const char*)ws + d.B + (size_t)(pm >> 4) * d.b_batch + (size_t)pn * d.b_tile;
        u.C = (char*)ws + d.C + (size_t)pm * d.c_rt + (size_t)pn * d.c_ct;
        if (d.scale_kind == 1) {
            u.scale = (pn < 4) ? 0.125f * LOG2E : ((pn >= 8 && pn < 12) ? 0.08838834764831845f * LOG2E : 1.0f);
            if (pn >= 4 && pn < 8) {
                u.C = (char*)ws + WS_KD + ((size_t)(4 * (pn - 4)) * MT + (size_t)pm * 256) * 64 * 2;
                u.SA = 128 * 64; u.SR = 64; u.SB = 2 * MT * 64; u.SX = MT * 64;
            } else if (pn >= 12) {
                u.C = (char*)ws + WS_KS + ((size_t)(2 * (pn - 12)) * MT + (size_t)pm * 256) * 128 * 2;
                u.SA = 128 * 128; u.SR = 128; u.SB = MT * 128; u.SX = 64;
            }
        } else if (d.scale_kind == 2) {
            u.C = (char*)ws + WS_VT + ((size_t)(2 * pm) * 512 + (size_t)(4 * pn)) * 8192 * 2;
            u.SA = 512 * 8192; u.SR = 64; u.SB = 2 * 8192; u.SX = 8192;
        }
        return true;
    } else {
        if (L >= 256) return false;
        const int z = L >> 3, t = L & 7, b = z >> 2, h = z & 3;
        u.A = (const char*)ws + d.A + (size_t)b * d.a_b + (size_t)h * d.a_h + (size_t)t * d.a_t;
        u.B = (const char*)ws + d.B + (size_t)b * d.b_b + (size_t)h * d.b_h + (size_t)t * d.b_t;
        u.C = (char*)ws + d.C + (size_t)b * d.c_b + (size_t)h * d.c_h + (size_t)t * d.c_t;
        return true;
    }
}

template <int mode>
__device__ __forceinline__ void epilogue(f32x4 (&acc)[2][2][4][2], const GUnit& u, int wr, int wc, int fr, int fq, LAS unsigned char* lds) {
    if (mode == 0) {
        bf16_t* base = (bf16_t*)u.C; const float sc = u.scale;
#pragma unroll
        for (int ai = 0; ai < 2; ++ai)
#pragma unroll
            for (int m = 0; m < 4; ++m) {
                bf16_t* rowp = base + (size_t)ai * u.SA + (size_t)(wr * 64 + m * 16 + fr) * u.SR + (wc >> 1) * u.SX + (wc & 1) * 32 + 8 * fq;
#pragma unroll
                for (int bj = 0; bj < 2; ++bj) {
                    const f32x4 v0 = acc[ai][bj][m][0] * sc, v1 = acc[ai][bj][m][1] * sc;
                    u32x4 w; w.x = cvtpk(v0[0], v0[1]); w.y = cvtpk(v0[2], v0[3]); w.z = cvtpk(v1[0], v1[1]); w.w = cvtpk(v1[2], v1[3]);
                    *(u32x4*)(rowp + (size_t)bj * u.SB) = w;
                }
            }
    } else if (mode == 1) {
        float* base = (float*)u.C; const float sc = u.scale;
#pragma unroll
        for (int ai = 0; ai < 2; ++ai)
#pragma unroll
            for (int m = 0; m < 4; ++m) {
                float* rowp = base + (size_t)ai * u.SA + (size_t)(wr * 64 + m * 16 + fr) * u.SR + (wc >> 1) * u.SX + (wc & 1) * 32 + 8 * fq;
#pragma unroll
                for (int bj = 0; bj < 2; ++bj) {
                    *(f32x4*)(rowp + (size_t)bj * u.SB) = acc[ai][bj][m][0] * sc;
                    *(f32x4*)(rowp + (size_t)bj * u.SB + 4) = acc[ai][bj][m][1] * sc;
                }
            }
    } else if (mode == 3) {
        LAS f32x2_t* X = (LAS f32x2_t*)(lds + 131200);
#pragma unroll
        for (int ai = 0; ai < 2; ++ai)
#pragma unroll
            for (int m = 0; m < 4; ++m) {
                float mx = -1e30f;
#pragma unroll
                for (int bj = 0; bj < 2; ++bj)
#pragma unroll
                    for (int n = 0; n < 2; ++n) { const f32x4 v = acc[ai][bj][m][n]; mx = fmaxf(mx, fmaxf(fmaxf(v[0], v[1]), fmaxf(v[2], v[3]))); }
                mx = fmaxf(mx, __shfl_xor(mx, 16)); mx = fmaxf(mx, __shfl_xor(mx, 32));
                float sum = 0.f;
#pragma unroll
                for (int bj = 0; bj < 2; ++bj)
#pragma unroll
                    for (int n = 0; n < 2; ++n) { f32x4 v = acc[ai][bj][m][n]; v[0] = ex2(v[0] - mx); v[1] = ex2(v[1] - mx); v[2] = ex2(v[2] - mx); v[3] = ex2(v[3] - mx);
                        acc[ai][bj][m][n] = v; sum += (v[0] + v[1]) + (v[2] + v[3]); }
                sum += __shfl_xor(sum, 16); sum += __shfl_xor(sum, 32);
                if (fq == 0) X[(ai * HALF + wr * 64 + m * 16 + fr) * 4 + wc] = (f32x2_t){mx, sum};
            }
        asm volatile("s_waitcnt lgkmcnt(0)" ::: "memory"); __builtin_amdgcn_s_barrier(); asm volatile("" ::: "memory");
        bf16_t* base = (bf16_t*)u.C;
#pragma unroll
        for (int ai = 0; ai < 2; ++ai)
#pragma unroll
            for (int m = 0; m < 4; ++m) {
                const int row = ai * HALF + wr * 64 + m * 16 + fr;
                const f32x2_t a0 = X[row * 4 + 0], a1 = X[row * 4 + 1], a2 = X[row * 4 + 2], a3 = X[row * 4 + 3];
                const float M = fmaxf(fmaxf(a0.x, a1.x), fmaxf(a2.x, a3.x));
                const float tot = (a0.y * ex2(a0.x - M) + a1.y * ex2(a1.x - M)) + (a2.y * ex2(a2.x - M) + a3.y * ex2(a3.x - M));
                const float own = (wc == 0) ? a0.x : (wc == 1) ? a1.x : (wc == 2) ? a2.x : a3.x;
                const float f = ex2(own - M) / tot;
                bf16_t* rowp = base + (size_t)ai * u.SA + (size_t)(wr * 64 + m * 16 + fr) * u.SR + (wc >> 1) * u.SX + (wc & 1) * 32 + 8 * fq;
#pragma unroll
                for (int bj = 0; bj < 2; ++bj) {
                    const f32x4 v0 = acc[ai][bj][m][0] * f, v1 = acc[ai][bj][m][1] * f;
                    u32x4 w; w.x = cvtpk(v0[0], v0[1]); w.y = cvtpk(v0[2], v0[3]); w.z = cvtpk(v1[0], v1[1]); w.w = cvtpk(v1[2], v1[3]);
                    *(u32x4*)(rowp + (size_t)bj * u.SB) = w;
                }
            }
    } else {
        bf16_t* base = (bf16_t*)u.C;
#pragma unroll
        for (int ai = 0; ai < 2; ++ai)
#pragma unroll
            for (int m = 0; m < 4; ++m) {
                bf16_t* rowp = base + (size_t)ai * u.SA + (size_t)(wr * 64 + m * 16 + fr) * u.SR + (wc >> 1) * u.SX + (wc & 1) * 32 + 8 * fq;
                float y[8];
#pragma unroll
                for (int n = 0; n < 2; ++n)
#pragma unroll
                    for (int j = 0; j < 4; ++j) {
                        const float g = acc[ai][0][m][n][j], up = acc[ai][1][m][n][j];
                        y[n * 4 + j] = g * __builtin_amdgcn_rcpf(1.0f + ex2(-g * LOG2E)) * up;
                    }
                u32x4 w; w.x = cvtpk(y[0], y[1]); w.y = cvtpk(y[2], y[3]); w.z = cvtpk(y[4], y[5]); w.w = cvtpk(y[6], y[7]);
                *(u32x4*)rowp = w;
            }
    }
}

template <int GI>
__device__ __forceinline__ void gemm_phase(LAS unsigned char* lds, unsigned char* ws, int G, int cblk) {
    constexpr GemmDesc g = make_desc(GI);
    int tid_ = threadIdx.x; asm volatile("" : "+v"(tid_));
    const int tid = tid_, wid = __builtin_amdgcn_readfirstlane(tid >> 6), lane = tid & 63, wr = wid >> 2, wc = wid & 3, fr = lane & 15, fq = lane >> 4;
    constexpr int K = g.K, nt = K / BK, lda = g.lda, ldb = g.ldb;
    unsigned voffA[2], voffB[2];
#pragma unroll
    for (int i = 0; i < 2; ++i) { int R, C; stage_rc(tid * 16 + i * 8192, R, C); const int Rb = (R & ~31) + perm32(R & 31);
        voffA[i] = (unsigned)(R * lda + C) * 2u; voffB[i] = (unsigned)(Rb * ldb + C) * 2u; }
    const size_t kstep = (size_t)(BK * 2);
    const size_t hstepA = (size_t)HALF * lda * 2, hstepB = (size_t)HALF * ldb * 2;
    const unsigned ldsw = (unsigned)wid * 1024u;
    const int aoff = lds_byte(wr * 64 + fr, fq * 8), boff = lds_byte(wc * 32 + fr, fq * 8);
#define PG8_SA(b, h) (((b) * 2 + (h)) * HTB)
#define PG8_SB(b, h) ((4 + (b) * 2 + (h)) * HTB)
#define PG8_STAGE(bufoff, gbase, voff) do { _Pragma("unroll") for (int _i = 0; _i < 2; ++_i) \
        __builtin_amdgcn_global_load_lds((const unsigned*)((const char*)(gbase) + (voff)[_i]), (LAS unsigned*)(lds + (bufoff) + ldsw + _i * 8192), 16, 0, 0); } while (0)
#define PG8_LDA(dst, b, h) do { _Pragma("unroll") for (int m = 0; m < 4; ++m) _Pragma("unroll") for (int k = 0; k < 2; ++k) dst[m][k] = *(const LAS bf16x8*)(lds + PG8_SA(b, h) + aoff + m * 2048 + k * 1024); } while (0)
#define PG8_LDB(dst, b, h) do { _Pragma("unroll") for (int n = 0; n < 2; ++n) _Pragma("unroll") for (int k = 0; k < 2; ++k) dst[n][k] = *(const LAS bf16x8*)(lds + PG8_SB(b, h) + boff + n * 2048 + k * 1024); } while (0)
#define PG8_MMA(ai, bj, At, Bt) do { __builtin_amdgcn_s_setprio(1); _Pragma("unroll") for (int m = 0; m < 4; ++m) _Pragma("unroll") for (int n = 0; n < 2; ++n) _Pragma("unroll") for (int k = 0; k < 2; ++k) \
        acc[ai][bj][m][n] = __builtin_amdgcn_mfma_f32_16x16x32_bf16(Bt[n][k], At[m][k], acc[ai][bj][m][n], 0, 0, 0); __builtin_amdgcn_s_setprio(0); } while (0)
#define PG8_WAIT_V(n) asm volatile("s_waitcnt vmcnt(" #n ")" ::: "memory")
#define PG8_WAIT_L(n) asm volatile("s_waitcnt lgkmcnt(" #n ")" ::: "memory")
#define PG8_BAR __builtin_amdgcn_s_barrier()
#define PG8_SCHED __builtin_amdgcn_sched_barrier(0)
    GUnit cur, nxt; int ui = 0;
    if (!sched_next<GI>(ws, 0, G, cblk, cur)) return;
    f32x4 acc[2][2][4][2];
#pragma unroll
    for (int a = 0; a < 2; ++a)
#pragma unroll
        for (int b = 0; b < 2; ++b)
#pragma unroll
            for (int m = 0; m < 4; ++m)
#pragma unroll
                for (int n = 0; n < 2; ++n) acc[a][b][m][n] = (f32x4){0.f, 0.f, 0.f, 0.f};
    bf16x8 At[4][2], B0[2][2], B1[2][2];
    const char* cA = cur.A; const char* cB = cur.B;
    PG8_STAGE(PG8_SB(0, 0), cB, voffB); PG8_STAGE(PG8_SB(0, 1), cB + hstepB, voffB); PG8_STAGE(PG8_SA(0, 0), cA, voffA); PG8_STAGE(PG8_SA(0, 1), cA + hstepA, voffA);
    if (wr == 1) PG8_BAR;
    PG8_WAIT_V(2); PG8_BAR;
    PG8_STAGE(PG8_SB(1, 0), cB + kstep, voffB); PG8_STAGE(PG8_SA(1, 0), cA + kstep, voffA); PG8_STAGE(PG8_SB(1, 1), cB + hstepB + kstep, voffB);
    PG8_WAIT_V(6); PG8_BAR;
    for (;;) {
        const bool has_next = sched_next<GI>(ws, ui + 1, G, cblk, nxt);
        const char* nA = has_next ? nxt.A : cA; const char* nB = has_next ? nxt.B : cB;
        for (int t = 0; t < nt; t += 2) {
            const bool last = (t == nt - 2);
            const char* a1 = cA + (size_t)(t + 1) * kstep;
            const char* a2 = last ? nA : cA + (size_t)(t + 2) * kstep; const char* b2 = last ? nB : cB + (size_t)(t + 2) * kstep;
            const char* a3 = a2 + kstep; const char* b3 = b2 + kstep;
            PG8_LDB(B0, 0, 0); PG8_LDB(B1, 0, 1); PG8_SCHED; PG8_LDA(At, 0, 0); PG8_STAGE(PG8_SA(1, 1), a1 + hstepA, voffA);
            PG8_WAIT_V(8); PG8_WAIT_L(0); PG8_BAR; PG8_MMA(0, 0, At, B0); PG8_MMA(0, 1, At, B1); PG8_BAR; PG8_SCHED;
            PG8_LDA(At, 0, 1); PG8_STAGE(PG8_SB(0, 0), b2, voffB); PG8_STAGE(PG8_SB(0, 1), b2 + hstepB, voffB); PG8_STAGE(PG8_SA(0, 0), a2, voffA);
            PG8_WAIT_V(8); PG8_WAIT_L(0); PG8_BAR; PG8_MMA(1, 0, At, B0); PG8_MMA(1, 1, At, B1); PG8_BAR; PG8_SCHED;
            PG8_LDB(B0, 1, 0); PG8_LDB(B1, 1, 1); PG8_SCHED; PG8_LDA(At, 1, 0); PG8_STAGE(PG8_SA(0, 1), a2 + hstepA, voffA);
            PG8_WAIT_V(8); PG8_WAIT_L(0); PG8_BAR; PG8_MMA(0, 0, At, B0); PG8_MMA(0, 1, At, B1); PG8_BAR; PG8_SCHED;
            PG8_LDA(At, 1, 1); PG8_STAGE(PG8_SB(1, 0), b3, voffB); PG8_STAGE(PG8_SB(1, 1), b3 + hstepB, voffB); PG8_STAGE(PG8_SA(1, 0), a3, voffA);
            PG8_WAIT_V(8); PG8_WAIT_L(0); PG8_BAR; PG8_MMA(1, 0, At, B0); PG8_MMA(1, 1, At, B1); PG8_BAR; PG8_SCHED;
        }
        if (wr == 0) PG8_BAR;
        epilogue<g.mode>(acc, cur, wr, wc, fr, fq, lds);
        if (!has_next) break;
#pragma unroll
        for (int a = 0; a < 2; ++a)
#pragma unroll
            for (int b = 0; b < 2; ++b)
#pragma unroll
                for (int m = 0; m < 4; ++m)
#pragma unroll
                    for (int n = 0; n < 2; ++n) acc[a][b][m][n] = (f32x4){0.f, 0.f, 0.f, 0.f};
        cur = nxt; cA = nA; cB = nB; ++ui;
        if (wr == 1) PG8_BAR;
    }
    PG8_WAIT_V(0);
    PG8_BAR;
#undef PG8_SA
#undef PG8_SB
#undef PG8_STAGE
#undef PG8_LDA
#undef PG8_LDB
#undef PG8_MMA
#undef PG8_WAIT_V
#undef PG8_WAIT_L
#undef PG8_BAR
#undef PG8_SCHED
}
}

#define XB_TMO      128
#define XB_XCNT(j)  (256  + 64 * (j))
#define XB_XSUB(j)  (1280 + 64 * (j))
#define XB_XGEN(j)  (2304 + 64 * (j))
#define XB_TOP      3328
#define XB_TOPGEN   3392
#define XCD_BAR_WORDS 3456
#define XB_SPIN_CAP (1u << 18)

__device__ __forceinline__ unsigned xb_ld(unsigned* p)              { return __hip_atomic_load(p, __ATOMIC_RELAXED, __HIP_MEMORY_SCOPE_AGENT); }
__device__ __forceinline__ unsigned xb_add(unsigned* p, unsigned v) { return __hip_atomic_fetch_add(p, v, __ATOMIC_RELAXED, __HIP_MEMORY_SCOPE_AGENT); }
__device__ __forceinline__ unsigned xb_xcc_id() { return (unsigned)__builtin_amdgcn_s_getreg((3 << 11) | 20) & 0xFu; }
#define XB_SPIN(cond, bar) do { unsigned _sp = 0; while (cond) { __builtin_amdgcn_s_sleep(1); \
    if ((++_sp & 255u) == 0u) { if (xb_ld(&(bar)[XB_TMO])) break; if (_sp > XB_SPIN_CAP) { atomicAdd(&(bar)[XB_TMO], 1u); break; } } } } while (0)

struct XcdBarrier {
    unsigned* bar; unsigned x;
    volatile LAS unsigned* st;
};

__device__ __forceinline__ XcdBarrier xcd_barrier_post(unsigned* bar, volatile LAS unsigned* st) {
    XcdBarrier b; b.bar = bar; b.x = xb_xcc_id(); b.st = st;
    if (threadIdx.x == 0) (void)xb_add(&bar[XB_XCNT(b.x)], 1u);
    return b;
}
__device__ __forceinline__ void xcd_barrier_complete(unsigned* bar, unsigned x, unsigned& nloc, unsigned& nx) {
    const unsigned G = gridDim.x * gridDim.y * gridDim.z;
    unsigned sum, cnt, mine, sp = 0u;
    for (;;) {
        sum = 0u; cnt = 0u; mine = 0u;
#pragma unroll
        for (unsigned j = 0; j < 16; ++j) { const unsigned c = xb_ld(&bar[XB_XCNT(j)]); sum += c; cnt += (c > 0u) ? 1u : 0u; mine = (j == x) ? c : mine; }
        if (sum == G) break;
        __builtin_amdgcn_s_sleep(1);
        if ((++sp & 255u) == 0u) { if (xb_ld(&bar[XB_TMO])) break; if (sp > XB_SPIN_CAP) { atomicAdd(&bar[XB_TMO], 1u); break; } }
    }
    nloc = mine > 0u ? mine : 1u; nx = cnt > 0u ? cnt : 1u;
}

__device__ __forceinline__ void xcd_barrier(const XcdBarrier& b) {
    asm volatile("s_waitcnt vmcnt(0)" ::: "memory");
    __syncthreads();
    if (threadIdx.x == 0) {
        unsigned* bar = b.bar;
        __builtin_amdgcn_s_waitcnt(0);
        unsigned nloc = b.st[0], nx = b.st[1];
        if (nloc == 0u) { xcd_barrier_complete(bar, b.x, nloc, nx); b.st[0] = nloc; b.st[1] = nx; }
        const unsigned old = xb_add(&bar[XB_XSUB(b.x)], 1u);
        const unsigned gen = old / nloc;
        if (old + 1u == (gen + 1u) * nloc) {
            __builtin_amdgcn_fence(__ATOMIC_RELEASE, "agent");
            asm volatile("s_waitcnt vmcnt(0)" ::: "memory");
            const unsigned og = xb_add(&bar[XB_TOP], 1u);
            const unsigned tg = og / nx;
            if (og + 1u == (tg + 1u) * nx) xb_add(&bar[XB_TOPGEN], 1u);
            else XB_SPIN(xb_ld(&bar[XB_TOPGEN]) == tg, bar);
            __builtin_amdgcn_fence(__ATOMIC_ACQUIRE, "agent");
            xb_add(&bar[XB_XGEN(b.x)], 1u);
            asm volatile("s_waitcnt vmcnt(0)" ::: "memory");
        } else {
            XB_SPIN(xb_ld(&bar[XB_XGEN(b.x)]) == gen, bar);
            __builtin_amdgcn_fence(__ATOMIC_ACQUIRE, "agent");
            asm volatile("s_waitcnt vmcnt(0)" ::: "memory");
        }
    }
    __syncthreads();
}

__device__ __forceinline__ void tr_item(const float* W, int N, int K, int k0, int n0, bf16_t* dst, LAS float* scr, int lane) {
#pragma unroll 8
    for (int i = 0; i < 32; ++i) { const int kk = 2 * i + (lane >> 5); scr[kk * 33 + (lane & 31)] = W[(size_t)(k0 + kk) * N + n0 + (lane & 31)]; }
    asm volatile("s_waitcnt lgkmcnt(0)" ::: "memory");
    const int c = lane & 7;
#pragma unroll
    for (int j = 0; j < 4; ++j) { const int n = (lane >> 3) + 8 * j; const LAS float* s = scr + (8 * c) * 33 + n;
        u32x4 o; o.x = cvtpk(s[0 * 33], s[1 * 33]); o.y = cvtpk(s[2 * 33], s[3 * 33]); o.z = cvtpk(s[4 * 33], s[5 * 33]); o.w = cvtpk(s[6 * 33], s[7 * 33]);
        *(u32x4*)(dst + (size_t)n * K + k0 + 8 * c) = o; }
    asm volatile("s_waitcnt lgkmcnt(0)" ::: "memory");
}

__device__ __forceinline__ void rms_row_bf16(const float* xrow, const float* g, bf16_t* orow, int lane) {
    const f32x4* xr = (const f32x4*)xrow + lane;
    f32x4 v[8]; float s = 0.f;
#pragma unroll
    for (int j = 0; j < 8; ++j) { v[j] = xr[64 * j]; s += (v[j].x * v[j].x + v[j].y * v[j].y) + (v[j].z * v[j].z + v[j].w * v[j].w); }
    const float r = 1.0f / sqrtf(wave_sum(s) * (1.0f / DM) + EPS);
    const f32x4* gr = (const f32x4*)g + lane;
    u32x2* o8 = (u32x2*)orow + lane;
#pragma unroll
    for (int j = 0; j < 8; ++j) { const f32x4 gv = gr[64 * j]; u32x2 w; w.x = cvtpk(v[j].x * r * gv.x, v[j].y * r * gv.y); w.y = cvtpk(v[j].z * r * gv.z, v[j].w * r * gv.w); o8[64 * j] = w; }
}

__device__ __forceinline__ void prologue(const Params& p, LAS unsigned char* lds, int G, int blk) {
    const int tid = threadIdx.x, lane = tid & 63, wave = __builtin_amdgcn_readfirstlane(tid >> 6);
    LAS float* scr = (LAS float*)(lds + wave * 16384);
    const int gw = blk * 8 + wave, NGW = G * 8;
    unsigned char* ws = p.ws;
    bf16_t* Wqk = (bf16_t*)(ws + WS_WQK); bf16_t* Wv = (bf16_t*)(ws + WS_WV); bf16_t* Wout = (bf16_t*)(ws + WS_WOUT);
    bf16_t* Wmkv = (bf16_t*)(ws + WS_WMKV); bf16_t* Wmo = (bf16_t*)(ws + WS_WMO); bf16_t* Wgu = (bf16_t*)(ws + WS_WGU); bf16_t* Wdn = (bf16_t*)(ws + WS_WDN);
    constexpr int I0 = 32 * 192, I1 = 32 * 64, I2 = 32 * 128, I3 = 32 * 64, I4 = 32 * 352, I5 = 88 * 64;
    constexpr int NIT = I0 + I1 + I2 + I3 + I4 + I5;
    for (int it = gw; it < NIT; it += NGW) {
        int r = it;
        if (r < I0) { const int kb = r / 192, nb = r % 192, n0 = nb * 32; bf16_t* dst;
            if (n0 < 2048) dst = Wqk + (size_t)n0 * 2048;
            else if (n0 < 3072) dst = Wv + (size_t)(n0 - 2048) * 2048;
            else if (n0 < 5120) dst = Wqk + (size_t)(2048 + n0 - 3072) * 2048;
            else dst = Wv + (size_t)(1024 + n0 - 5120) * 2048;
            tr_item(p.w_in, 6144, 2048, kb * 64, n0, dst, scr, lane); continue; }
        r -= I0;
        if (r < I1) { const int kb = r / 64, nb = r % 64; tr_item(p.w_out, 2048, 2048, kb * 64, nb * 32, Wout + (size_t)(nb * 32) * 2048, scr, lane); continue; }
        r -= I1;
        if (r < I2) { const int kb = r / 128, nb = r % 128; tr_item(p.w_mkv, 4096, 2048, kb * 64, nb * 32, Wmkv + (size_t)(nb * 32) * 2048, scr, lane); continue; }
        r -= I2;
        if (r < I3) { const int kb = r / 64, nb = r % 64; tr_item(p.w_mo, 2048, 2048, kb * 64, nb * 32, Wmo + (size_t)(nb * 32) * 2048, scr, lane); continue; }
        r -= I3;
        if (r < I4) { const int kb = r / 352, nb = r % 352, n0 = nb * 32; int drow;
            if (n0 < DFF) drow = 256 * (n0 / 128) + (n0 % 128); else { const int c2 = n0 - DFF; drow = 256 * (c2 / 128) + 128 + (c2 % 128); }
            tr_item(p.w_gu, 2 * DFF, 2048, kb * 64, n0, Wgu + (size_t)drow * 2048, scr, lane); continue; }
        r -= I4;
        { const int kb = r / 64, nb = r % 64; tr_item(p.w_down, 2048, DFF, kb * 64, nb * 32, Wdn + (size_t)(nb * 32) * DFF, scr, lane); }
    }
    { bf16_t* Wmq = (bf16_t*)(ws + WS_WMQ); const int gt = blk * 512 + tid, NGT = G * 512;
      for (int i = gt; i < 2048 * 2048 / 4; i += NGT) { const f32x4 v = ((const f32x4*)p.w_mq)[i]; u32x2 w; w.x = cvtpk(v.x, v.y); w.y = cvtpk(v.z, v.w); ((u32x2*)Wmq)[i] = w; } }
    bf16_t* H = (bf16_t*)(ws + WS_H); bf16_t* memn = (bf16_t*)(ws + WS_MEMN);
    for (int m = gw; m < MT; m += NGW) rms_row_bf16(p.x + (size_t)m * DM, p.g_mix_pre, H + (size_t)m * DM, lane);
    for (int m = gw; m < NB * 256; m += NGW) rms_row_bf16(p.mem + (size_t)m * DM, p.g_mem_kv, memn + (size_t)m * DM, lane);
}

template <bool HAS_H, bool XIN_BF, bool XOUT_BF>
__device__ __forceinline__ void row_pass(const bf16_t* y, const void* xin, void* xout, const float* g_post, const float* g_pre, bf16_t* hout, int G, int blk) {
    const int tid = threadIdx.x, lane = tid & 63, wave = tid >> 6;
    const int gw = blk * 8 + wave, NGW = G * 8;
    for (int row = gw; row < MT; row += NGW) {
        const u32x2* yr = (const u32x2*)(y + (size_t)row * DM) + lane;
        const f32x4* xr = (const f32x4*)((const float*)xin + (size_t)row * DM) + lane;
        const u32x2* xrb = (const u32x2*)((const bf16_t*)xin + (size_t)row * DM) + lane;
        f32x4 yv[8], xv[8]; float s = 0.f;
#pragma unroll
        for (int j = 0; j < 8; ++j) { const u32x2 w = yr[64 * j]; yv[j] = (f32x4){bf_lo(w.x), bf_hi(w.x), bf_lo(w.y), bf_hi(w.y)};
            if (XIN_BF) { const u32x2 xw = xrb[64 * j]; xv[j] = (f32x4){bf_lo(xw.x), bf_hi(xw.x), bf_lo(xw.y), bf_hi(xw.y)}; } else xv[j] = xr[64 * j];
            s += (yv[j].x * yv[j].x + yv[j].y * yv[j].y) + (yv[j].z * yv[j].z + yv[j].w * yv[j].w); }
        const float r = 1.0f / sqrtf(wave_sum(s) * (1.0f / DM) + EPS);
        const f32x4* gp = (const f32x4*)g_post + lane;
        f32x4* xo = (f32x4*)((float*)xout + (size_t)row * DM) + lane;
        u32x2* xob = (u32x2*)((bf16_t*)xout + (size_t)row * DM) + lane;
        float s1 = 0.f;
#pragma unroll
        for (int j = 0; j < 8; ++j) { const f32x4 gv = gp[64 * j]; xv[j] = xv[j] + yv[j] * r * gv;
            if (XOUT_BF) { u32x2 w; w.x = cvtpk(xv[j].x, xv[j].y); w.y = cvtpk(xv[j].z, xv[j].w); xob[64 * j] = w; } else xo[64 * j] = xv[j];
            s1 += (xv[j].x * xv[j].x + xv[j].y * xv[j].y) + (xv[j].z * xv[j].z + xv[j].w * xv[j].w); }
        if (HAS_H) {
            const float r1 = 1.0f / sqrtf(wave_sum(s1) * (1.0f / DM) + EPS);
            const f32x4* gq = (const f32x4*)g_pre + lane;
            u32x2* ho = (u32x2*)(hout + (size_t)row * DM) + lane;
#pragma unroll
            for (int j = 0; j < 8; ++j) { const f32x4 gv = gq[64 * j]; u32x2 w; w.x = cvtpk(xv[j].x * r1 * gv.x, xv[j].y * r1 * gv.y); w.y = cvtpk(xv[j].z * r1 * gv.z, xv[j].w * r1 * gv.w); ho[64 * j] = w; }
        }
    }
}

__device__ __forceinline__ void softmax_pass(const float* S, bf16_t* P, int G, int blk) {
    const int tid = threadIdx.x, lane = tid & 63, wave = tid >> 6;
    const int gw = blk * 8 + wave, NGW = G * 8;
    for (int row = gw; row < MT; row += NGW) {
        const f32x4* sr = (const f32x4*)(S + (size_t)row * 1024) + lane;
        u32x2* pr = (u32x2*)(P + (size_t)row * 1024) + lane;
        f32x4 v[4];
#pragma unroll
        for (int h = 0; h < 4; ++h) v[h] = sr[64 * h];
#pragma unroll
        for (int h = 0; h < 4; ++h) {
            const float mx = wave_max(fmaxf(fmaxf(v[h].x, v[h].y), fmaxf(v[h].z, v[h].w)));
            f32x4 e; e.x = ex2(v[h].x - mx); e.y = ex2(v[h].y - mx); e.z = ex2(v[h].z - mx); e.w = ex2(v[h].w - mx);
            const float inv = 1.0f / wave_sum((e.x + e.y) + (e.z + e.w));
            u32x2 w; w.x = cvtpk(e.x * inv, e.y * inv); w.y = cvtpk(e.z * inv, e.w * inv); pr[64 * h] = w;
        }
    }
}

#ifndef PROBE_DIFF_REPS
#define PROBE_DIFF_REPS 1
#endif
#ifndef PROBE_SB_REPS
#define PROBE_SB_REPS 1
#endif
constexpr int A_KBUF = 16384, A_VBUF = 16384, A_KOFF = 0, A_VOFF = 2 * A_KBUF, A_TAB = A_VOFF + 2 * A_VBUF, A_FLAG = A_TAB + 1024;
#define MFMA32(a, b, c) __builtin_amdgcn_mfma_f32_32x32x16_bf16((a), (b), (c), 0, 0, 0)
#define SCHEDB() __builtin_amdgcn_sched_barrier(0)
__device__ __forceinline__ int crow(int r, int h) { return (r & 3) + 8 * (r >> 2) + 4 * h; }

template <int KD>
__device__ __forceinline__ void tile_dma(const bf16_t* Kg, const bf16_t* Vg, LAS unsigned char* kb, LAS unsigned char* vb, int wid, int lane) {
    if (KD == 128) {
#pragma unroll
        for (int i = 0; i < 2; ++i) {
            const int kc = wid * 2 + i, rho = 4 * kc + (lane >> 4), x = lane & 15, i5 = rho & 31;
            const int key = (rho & 32) + 16 * ((i5 >> 2) & 1) + 8 * (i5 >> 4) + 4 * ((i5 >> 3) & 1) + (i5 & 3);
            const bf16_t* src = Kg + (size_t)key * KD + ((x ^ (rho & 15)) * 8);
            __builtin_amdgcn_global_load_lds((const unsigned*)src, (LAS unsigned*)(kb + kc * 1024), 16, 0, 0);
        }
    } else {
        const int kc = wid, rho = 8 * kc + (lane >> 3), x = lane & 7, i5 = rho & 31;
        const int key = (rho & 32) + 16 * ((i5 >> 2) & 1) + 8 * (i5 >> 4) + 4 * ((i5 >> 3) & 1) + (i5 & 3);
        const bf16_t* src = Kg + (size_t)key * KD + ((x ^ ((rho >> 1) & 7)) * 8);
        __builtin_amdgcn_global_load_lds((const unsigned*)src, (LAS unsigned*)(kb + kc * 1024), 16, 0, 0);
    }
#pragma unroll
    for (int i = 0; i < 2; ++i) {
        const int vc = wid * 2 + i, rho = 8 * vc + (lane >> 3), x = lane & 7;
        const bf16_t* src = Vg + (size_t)rho * 64 + ((x ^ ((rho >> 1) & 7)) * 8);
        __builtin_amdgcn_global_load_lds((const unsigned*)src, (LAS unsigned*)(vb + vc * 1024), 16, 0, 0);
    }
}
__device__ __forceinline__ bf16x8 pack8(const f32x16& s, int o) {
    u32x4 w; w.x = cvtpk(s[o], s[o + 1]); w.y = cvtpk(s[o + 2], s[o + 3]); w.z = cvtpk(s[o + 4], s[o + 5]); w.w = cvtpk(s[o + 6], s[o + 7]);
    return __builtin_bit_cast(bf16x8, w);
}
__device__ __forceinline__ void pv_acc(f32x16 (&O)[4], const f32x16& s0, const f32x16& s1, const LAS unsigned char* vbase, int xv) {
#pragma unroll
    for (int g = 0; g < 4; ++g) {
        const int kbk = g >> 1, s = g & 1;
        const int co = ((4 * kbk + s) ^ xv) << 4;
        bf16x8 vf[4];
#pragma unroll
        for (int db = 0; db < 4; ++db) vf[db] = *(const LAS bf16x8*)(vbase + db * 4096 + co);
        const bf16x8 pf = pack8(kbk ? s1 : s0, 8 * s);
#pragma unroll
        for (int db = 0; db < 4; ++db) O[db] = MFMA32(pf, vf[db], O[db]);
        SCHEDB();
    }
}
template <int NKS, int ROWB>
__device__ __forceinline__ void qk_tile(f32x16& s0, f32x16& s1, const LAS unsigned char* kb, int xk, const bf16x8* qf) {
    bf16x8 a[2][2];
    { const int co = (0 ^ xk) << 4; a[0][0] = *(const LAS bf16x8*)(kb + co); a[0][1] = *(const LAS bf16x8*)(kb + 32 * ROWB + co); }
#pragma unroll
    for (int ks = 0; ks < NKS; ++ks) {
        if (ks + 1 < NKS) { const int co = ((2 * (ks + 1)) ^ xk) << 4; a[(ks + 1) & 1][0] = *(const LAS bf16x8*)(kb + co); a[(ks + 1) & 1][1] = *(const LAS bf16x8*)(kb + 32 * ROWB + co); }
        s0 = MFMA32(a[ks & 1][0], qf[ks], s0); s1 = MFMA32(a[ks & 1][1], qf[ks], s1);
        SCHEDB();
    }
}

__device__ __forceinline__ void smax_update(f32x16& s0, f32x16& s1, float& m, float& l, f32x16 (&O)[4], int hh) {
    float mx = fmaxf(s0[0], s1[0]);
#pragma unroll
    for (int r = 1; r < 16; ++r) mx = fmaxf(mx, fmaxf(s0[r], s1[r]));
    mx = fmaxf(mx, __shfl_xor(mx, 32));
    if (__any(mx > m + 8.0f)) {
        const float mn = fmaxf(m, mx);
        const float alpha = ex2(m - mn);
        l *= alpha; m = mn;
        int hl = hh; asm volatile("" : "+v"(hl));
#pragma unroll
        for (int r = 0; r < 16; ++r) { const float a = __shfl(alpha, crow(r, hl));
#pragma unroll
            for (int db = 0; db < 4; ++db) O[db][r] *= a; }
    }
    float sum = 0.f;
#pragma unroll
    for (int r = 0; r < 16; ++r) { s0[r] = ex2(s0[r] - m); s1[r] = ex2(s1[r] - m); sum += s0[r] + s1[r]; }
    l += sum;
}

#define MX3(a, b, c) __builtin_fmaxf(__builtin_fmaxf((a), (b)), (c))
__device__ __forceinline__ void diff_unit(const Params& p, LAS unsigned char* lds, int b, int h, int qb, float lam) {
    int tid_ = threadIdx.x; asm volatile("" : "+v"(tid_));
    const int tid = tid_, lane = tid & 63, wid = __builtin_amdgcn_readfirstlane(tid >> 6), c = lane & 31, hh = lane >> 5;
    const bf16_t* QK = (const bf16_t*)(p.ws + WS_QK); const bf16_t* VT = (const bf16_t*)(p.ws + WS_VT); bf16_t* AO = (bf16_t*)(p.ws + WS_AO);
    const size_t rowbase = (size_t)b * SEQ;
    const int q0 = qb * 256 + wid * 32, mylast = q0 >> 6, NT = 4 * qb + 4;
    const int xk = ((c >> 1) & 7) ^ hh, xv = ((c >> 1) & 7) ^ (2 * hh);
    LAS float* tab = (LAS float*)(lds + A_TAB);
    if (tid < 256) { const int d = tid - 64, n = d < 0 ? -d : d; int bk = (n < 8) ? n : min(15, 2 + (31 - __clz(n * n))); if (d < 0) bk += 16;
        tab[tid] = (p.rel_bias[bk * 8 + h] - p.rel_bias[15 * 8 + h]) * LOG2E; }
    const bf16_t* Vg0 = VT + ((size_t)h * 512 + (size_t)b * 64) * 8192;
    unsigned* park = (unsigned*)(p.ws + WS_PARK) + ((size_t)(blockIdx.x * 8 + wid) * 32) * 64 + lane;
    const bf16x8 ones = (bf16x8){0x3f80, 0x3f80, 0x3f80, 0x3f80, 0x3f80, 0x3f80, 0x3f80, 0x3f80};
    f32x16 O[4];
#pragma unroll
    for (int mp = 0; mp < 2; ++mp) {
        const bf16_t* Kg0 = (const bf16_t*)(p.ws + WS_KD) + ((size_t)(2 * h + mp) * MT + rowbase) * 64;
        tile_dma<64>(Kg0, Vg0, lds + A_KOFF, lds + A_VOFF, wid, lane);
        const bf16_t* qp = QK + (rowbase + q0 + c) * 4096 + h * 128 + 64 * mp + hh * 8;
        bf16x8 qf[4];
#pragma unroll
        for (int ks = 0; ks < 4; ++ks) qf[ks] = *(const bf16x8*)(qp + 16 * ks);
#pragma unroll
        for (int db = 0; db < 4; ++db) O[db] = (f32x16){};
        f32x16 L = (f32x16){};
        f32x16 negm = (f32x16){};
        float m = 0.f;
        asm volatile("s_waitcnt vmcnt(0)" ::: "memory");
        __syncthreads();
        for (int jt = 0; jt < NT; ++jt) {
            const int cur = jt & 1;
            if (jt + 1 < NT) tile_dma<64>(Kg0 + (size_t)(jt + 1) * 4096, Vg0 + (size_t)(jt + 1) * 8192, lds + A_KOFF + (cur ^ 1) * A_KBUF, lds + A_VOFF + (cur ^ 1) * A_VBUF, wid, lane);
            if (jt <= mylast) {
                const LAS unsigned char* kb = lds + A_KOFF + cur * A_KBUF + c * 128;
                const LAS unsigned char* vb = lds + A_VOFF + cur * A_VBUF + c * 128;
                f32x16 s0, s1;
                {
                    bf16x8 a[2][2];
                    { const int co = (0 ^ xk) << 4; a[0][0] = *(const LAS bf16x8*)(kb + co); a[0][1] = *(const LAS bf16x8*)(kb + 4096 + co); }
#pragma unroll
                    for (int ks = 0; ks < 4; ++ks) {
                        if (ks + 1 < 4) { const int co = ((2 * (ks + 1)) ^ xk) << 4; a[(ks + 1) & 1][0] = *(const LAS bf16x8*)(kb + co); a[(ks + 1) & 1][1] = *(const LAS bf16x8*)(kb + 4096 + co); }
                        if (ks == 0) { s0 = MFMA32(a[0][0], qf[0], negm); s1 = MFMA32(a[0][1], qf[0], negm); }
                        else { s0 = MFMA32(a[ks & 1][0], qf[ks], s0); s1 = MFMA32(a[ks & 1][1], qf[ks], s1); }
                        SCHEDB();
                    }
                }
                if ((q0 - (64 * jt + 63)) < 91) {
                    const int idx0 = (q0 + c) - (64 * jt + 16 * hh) + 64;
#pragma unroll
                    for (int r = 0; r < 16; ++r) { s0[r] += tab[min(idx0 - r, 255)]; s1[r] += tab[min(idx0 - 32 - r, 255)]; if ((r & 3) == 3) SCHEDB(); }
                }
                float mx;
                { float a0 = MX3(s0[0], s0[1], s1[0]), a1 = MX3(s0[2], s0[3], s1[1]); a0 = MX3(a0, s1[2], s1[3]);
#pragma unroll
                  for (int r = 4; r < 16; r += 4) { a0 = MX3(a0, s0[r], s0[r + 1]); a1 = MX3(a1, s0[r + 2], s0[r + 3]); a0 = MX3(a0, s1[r], s1[r + 1]); a1 = MX3(a1, s1[r + 2], s1[r + 3]); }
                  mx = fmaxf(a0, a1); }
                { auto rr = __builtin_amdgcn_permlane32_swap(__float_as_uint(mx), __float_as_uint(mx), false, false); mx = fmaxf(__uint_as_float(rr[0]), __uint_as_float(rr[1])); }
                const bool first = (jt == 0);
                if (first || __any(mx > 8.0f)) {
                    const float dl = first ? mx : fmaxf(mx, 0.f);
                    m += dl;
#pragma unroll
                    for (int r = 0; r < 16; ++r) { s0[r] -= dl; s1[r] -= dl; }
#pragma unroll
                    for (int r = 0; r < 16; ++r) negm[r] = -m;
                    if (!first) {
                        const float alpha = ex2(-dl);
                        int hl = hh; asm volatile("" : "+v"(hl));
#pragma unroll
                        for (int r = 0; r < 16; ++r) { const float a = __shfl(alpha, crow(r, hl)); L[r] *= a;
#pragma unroll
                            for (int db = 0; db < 4; ++db) O[db][r] *= a; }
                    }
                }
#pragma unroll
                for (int r = 0; r < 16; ++r) { s0[r] = ex2(s0[r]); s1[r] = ex2(s1[r]); }
#pragma unroll
                for (int g = 0; g < 4; ++g) {
                    const int co = ((4 * (g >> 1) + (g & 1)) ^ xv) << 4;
                    bf16x8 vf[4];
#pragma unroll
                    for (int db = 0; db < 4; ++db) vf[db] = *(const LAS bf16x8*)(vb + db * 4096 + co);
                    const bf16x8 pf = pack8((g >> 1) ? s1 : s0, 8 * (g & 1));
#pragma unroll
                    for (int db = 0; db < 4; ++db) O[db] = MFMA32(pf, vf[db], O[db]);
                    L = MFMA32(pf, ones, L);
                    SCHEDB();
                }
            }
            asm volatile("s_waitcnt vmcnt(0)" ::: "memory");
            __syncthreads();
        }
#pragma unroll
        for (int r = 0; r < 16; ++r) { const float a = (mp == 0 ? 1.0f : lam) / L[r];
#pragma unroll
            for (int db = 0; db < 4; ++db) O[db][r] *= a; }
        if (mp == 0) {
#pragma unroll
            for (int db = 0; db < 4; ++db)
#pragma unroll
                for (int j = 0; j < 8; ++j) park[(db * 8 + j) * 64] = cvtpk(O[db][2 * j], O[db][2 * j + 1]);
        }
    }
    float gn[4];
#pragma unroll
    for (int db = 0; db < 4; ++db) gn[db] = p.diff_gain[32 * db + c] * 0.8f;
#pragma unroll
    for (int r = 0; r < 16; ++r) {
        const int qr = crow(r, hh);
        float o[4]; float ss = 0.f;
#pragma unroll
        for (int db = 0; db < 4; ++db) { const unsigned w = park[(db * 8 + (r >> 1)) * 64]; o[db] = ((r & 1) ? bf_hi(w) : bf_lo(w)) - O[db][r]; ss += o[db] * o[db]; }
#pragma unroll
        for (int off = 1; off < 32; off <<= 1) ss += __shfl_xor(ss, off);
        const float rs = 1.0f / sqrtf(ss * (1.0f / 128.0f) + EPS);
        bf16_t* op = AO + (rowbase + q0 + qr) * DM + h * 128 + c;
#pragma unroll
        for (int db = 0; db < 4; ++db) op[32 * db] = (bf16_t)(cvtpk(o[db] * rs * gn[db], 0.f) & 0xffffu);
    }
}
#undef MX3

__device__ __forceinline__ void sb_unit(const Params& p, LAS unsigned char* lds, int b, int h, int qb) {
    int tid_ = threadIdx.x; asm volatile("" : "+v"(tid_));
    const int tid = tid_, lane = tid & 63, wid = __builtin_amdgcn_readfirstlane(tid >> 6), c = lane & 31, hh = lane >> 5;
    const bf16_t* QK = (const bf16_t*)(p.ws + WS_QK); const bf16_t* VT = (const bf16_t*)(p.ws + WS_VT); bf16_t* AO = (bf16_t*)(p.ws + WS_AO);
    const size_t rowbase = (size_t)b * SEQ;
    const int q0 = qb * 256 + wid * 32, mylast = q0 >> 6, T0 = 4 * qb + 3;
    const int xk = (c & 15) ^ hh, xv = ((c >> 1) & 7) ^ (2 * hh);
    LAS unsigned* flag = (LAS unsigned*)(lds + A_FLAG);
    const bf16_t* Kg0 = (const bf16_t*)(p.ws + WS_KS) + ((size_t)h * MT + rowbase) * 128;
    const bf16_t* Vg0 = VT + ((size_t)(8 + h) * 512 + (size_t)b * 64) * 8192;
    tile_dma<128>(Kg0 + (size_t)T0 * 8192, Vg0 + (size_t)T0 * 8192, lds + A_KOFF, lds + A_VOFF, wid, lane);
    const bf16_t* qp = QK + (rowbase + q0 + c) * 4096 + 2048 + h * 128 + hh * 8;
    bf16x8 qf[8];
#pragma unroll
    for (int ks = 0; ks < 8; ++ks) qf[ks] = *(const bf16x8*)(qp + 16 * ks);
    f32x16 O[4];
#pragma unroll
    for (int db = 0; db < 4; ++db) O[db] = (f32x16){};
    float carry = 0.f; bool done = false;
    asm volatile("s_waitcnt vmcnt(0)" ::: "memory");
    __syncthreads();
    for (int jt = T0; jt >= 0; --jt) {
        const int cur = (T0 - jt) & 1;
        if (jt > 0) tile_dma<128>(Kg0 + (size_t)(jt - 1) * 8192, Vg0 + (size_t)(jt - 1) * 8192, lds + A_KOFF + (cur ^ 1) * A_KBUF, lds + A_VOFF + (cur ^ 1) * A_VBUF, wid, lane);
        if (jt <= mylast && !done) {
            const LAS unsigned char* kb = lds + A_KOFF + cur * A_KBUF + c * 256;
            const LAS unsigned char* vb = lds + A_VOFF + cur * A_VBUF + c * 128;
            f32x16 s0 = (f32x16){}, s1 = (f32x16){};
            qk_tile<8, 256>(s0, s1, kb, xk, qf);
            const bool diag = (jt == mylast);
            const int lim = (q0 + c) - (64 * jt + 16 * hh);
            float run = 0.f;
#pragma unroll
            for (int r = 15; r >= 0; --r) {
                const float z = s1[r]; const float sp = fmaxf(z, 0.f) + lg2(1.0f + ex2(-fabsf(z)));
                float lk = -sp, lb = z - sp;
                if (diag && !(r + 32 < lim)) { lk = 0.f; lb = -1e30f; }
                s1[r] = lb + run; run += lk;
            }
            const float T1 = run; run = 0.f;
#pragma unroll
            for (int r = 15; r >= 0; --r) {
                const float z = s0[r]; const float sp = fmaxf(z, 0.f) + lg2(1.0f + ex2(-fabsf(z)));
                float lk = -sp, lb = z - sp;
                if (diag && !(r < lim)) { lk = 0.f; lb = -1e30f; }
                s0[r] = lb + run; run += lk;
            }
            const float T0s = run;
            const float T1p = __shfl_xor(T1, 32), T0p = __shfl_xor(T0s, 32);
            const float off1 = carry + (hh ? 0.f : T1p);
            const float off0 = carry + T1 + T1p + (hh ? 0.f : T0p);
#pragma unroll
            for (int r = 0; r < 16; ++r) { s1[r] = ex2(s1[r] + off1); s0[r] = ex2(s0[r] + off0); }
            carry += (T1 + T1p) + (T0s + T0p);
            pv_acc(O, s0, s1, vb, xv);
            done = __all(carry < -60.0f);
        }
        if (lane == 0) flag[cur * 8 + wid] = done ? 1u : 0u;
        asm volatile("s_waitcnt vmcnt(0)" ::: "memory");
        __syncthreads();
        const u32x4 f0 = *(const LAS u32x4*)(flag + cur * 8), f1 = *(const LAS u32x4*)(flag + cur * 8 + 4);
        if ((f0.x & f0.y & f0.z & f0.w & f1.x & f1.y & f1.z & f1.w) != 0u) break;
    }
    float gn[4];
#pragma unroll
    for (int db = 0; db < 4; ++db) gn[db] = p.sb_gain[32 * db + c];
#pragma unroll
    for (int r = 0; r < 16; ++r) {
        const int qr = crow(r, hh);
        float ss = 0.f;
#pragma unroll
        for (int db = 0; db < 4; ++db) ss += O[db][r] * O[db][r];
#pragma unroll
        for (int off = 1; off < 32; off <<= 1) ss += __shfl_xor(ss, off);
        const float rs = 1.0f / sqrtf(ss * (1.0f / 128.0f) + EPS);
        bf16_t* op = AO + (rowbase + q0 + qr) * DM + 1024 + h * 128 + c;
#pragma unroll
        for (int db = 0; db < 4; ++db) op[32 * db] = (bf16_t)(cvtpk(O[db][r] * rs * gn[db], 0.f) & 0xffffu);
    }
    asm volatile("s_waitcnt vmcnt(0)" ::: "memory");
    __syncthreads();
}

__device__ __forceinline__ void attention_phase(const Params& p, LAS unsigned char* lds, int G, int blk) {
    float s1 = 0.f, s2 = 0.f;
    for (int i = 0; i < 64; ++i) { s1 += p.lq1[i] * p.lk1[i]; s2 += p.lq2[i] * p.lk2[i]; }
    const float lam = expf(s1) - expf(s2) + 0.2f;
    const int v = (G % 8 == 0) ? (blk % 8) * (G / 8) + blk / 8 : blk;
    for (int rep = 0; rep < PROBE_DIFF_REPS; ++rep)
    for (int u = v; u < 1024; u += G) {
        const int bh = (u & 255) >> 2, s = u & 3, i = u >> 8;
        const int qb = (i == 0) ? s : (i == 1) ? 7 - s : (i == 2) ? 8 + s : 15 - s;
#ifndef NO_DIFF
        diff_unit(p, lds, bh >> 3, bh & 7, qb, lam);
#endif
    }
    for (int rep = 0; rep < PROBE_SB_REPS; ++rep)
    for (int u = v; u < 1024; u += G) {
        const int bh = (u & 255) >> 2, s = u & 3, i = u >> 8;
        const int qb = (i == 0) ? s : (i == 1) ? 7 - s : (i == 2) ? 8 + s : 15 - s;
#ifndef NO_SB
        sb_unit(p, lds, bh >> 3, bh & 7, qb);
#endif
    }
}

constexpr int LDS_BYTES = 143360;

__global__ void __launch_bounds__(512) fwd_megakernel(Params p) {
    extern __shared__ __attribute__((aligned(16))) unsigned char lds_raw[];
    LAS unsigned char* lds = (LAS unsigned char*)lds_raw;
    cg::grid_group grid = cg::this_grid();
    const int G = gridDim.x, blk = blockIdx.x;
    unsigned char* ws = p.ws;

#ifdef ONLY_GEMM
#define GEMM(gi) do { if (gi == ONLY_GEMM) pg8::gemm_phase<gi>(lds, ws, G, blk); } while (0)
#else
#define GEMM(gi) pg8::gemm_phase<gi>(lds, ws, G, blk)
#endif
    volatile LAS unsigned* xst = (volatile LAS unsigned*)(lds + 131072);
    unsigned* barw = (unsigned*)ws;
    if (threadIdx.x < 2) xst[threadIdx.x] = 0u;
    if (blk == 0) for (int i = threadIdx.x; i < XCD_BAR_WORDS; i += 512) barw[i] = 0u;
    prologue(p, lds, G, blk);
#ifdef PROBE_PRO2
    __syncthreads(); prologue(p, lds, G, blk);
#endif
    grid.sync();
    XcdBarrier xbar = xcd_barrier_post(barw, xst);
    GEMM(0); GEMM(1); GEMM(2);
#ifdef PROBE_G012
    GEMM(0); GEMM(1); GEMM(2);
#endif
    GSYNC();
    attention_phase(p, lds, G, blk); GSYNC();
    GEMM(3); GEMM(4); GEMM(5); GSYNC();
    row_pass<true, false, true>((const bf16_t*)(ws + WS_MIX), p.x, ws + WS_XR, p.g_mix_post, p.g_mem_pre, (bf16_t*)(ws + WS_H), G, blk);
#ifdef PROBE_R12
    row_pass<true, false, true>((const bf16_t*)(ws + WS_MIX), p.x, ws + WS_XR, p.g_mix_post, p.g_mem_pre, (bf16_t*)(ws + WS_H), G, blk);
#endif
    GSYNC();
    GEMM(6); GSYNC();
    GEMM(7); GSYNC();
    row_pass<true, true, true>((const bf16_t*)(ws + WS_MEMO), ws + WS_XR, ws + WS_XR, p.g_mem_post, p.g_ffn_pre, (bf16_t*)(ws + WS_H), G, blk); GSYNC();
    GEMM(8);
#ifdef PROBE_G8
    GEMM(8);
#endif
    GSYNC();
    GEMM(9);
#ifdef PROBE_G9
    GEMM(9);
#endif
    GSYNC();
    row_pass<false, true, false>((const bf16_t*)(ws + WS_FO), ws + WS_XR, p.out, p.g_ffn_post, nullptr, nullptr, G, blk);
#undef GEMM
}

extern "C" void kernel_launch(void* const* d_in, const int* in_sizes, int n_in, void* d_out, int out_size, void* d_ws, size_t ws_size, hipStream_t stream) {
    static int grid_blocks = 0;
    if (grid_blocks == 0) {
        if (n_in != 23 || ws_size < WS_END) { fprintf(stderr, "kernel_launch: unexpected n_in %d / ws %zu\n", n_in, ws_size); grid_blocks = -1; return; }
        int dev = 0, cus = 0, per_cu = 0;
        hipGetDevice(&dev);
        hipDeviceGetAttribute(&cus, hipDeviceAttributeMultiprocessorCount, dev);
        if (hipFuncSetAttribute((const void*)fwd_megakernel, hipFuncAttributeMaxDynamicSharedMemorySize, LDS_BYTES) != hipSuccess) { fprintf(stderr, "kernel_launch: hipFuncSetAttribute failed\n"); }
        if (hipOccupancyMaxActiveBlocksPerMultiprocessor(&per_cu, (const void*)fwd_megakernel, 512, LDS_BYTES) != hipSuccess || per_cu < 1) { fprintf(stderr, "kernel_launch: occupancy query gave %d\n", per_cu); per_cu = 1; }
        (void)hipGetLastError();
        grid_blocks = cus * 1;
        if (grid_blocks > 256) grid_blocks = 256;
    }
    if (grid_blocks < 0) return;
    Params p{};
    const float* const* in = (const float* const*)d_in;
    p.x = in[0]; p.mem = in[1]; p.w_in = in[2]; p.w_out = in[3]; p.rel_bias = in[4];
    p.lq1 = in[5]; p.lk1 = in[6]; p.lq2 = in[7]; p.lk2 = in[8];
    p.diff_gain = in[9]; p.sb_gain = in[10]; p.g_mix_pre = in[11]; p.g_mix_post = in[12];
    p.w_mq = in[13]; p.w_mkv = in[14]; p.w_mo = in[15]; p.g_mem_kv = in[16]; p.g_mem_pre = in[17]; p.g_mem_post = in[18];
    p.w_gu = in[19]; p.w_down = in[20]; p.g_ffn_pre = in[21]; p.g_ffn_post = in[22];
    p.out = (float*)d_out; p.ws = (unsigned char*)d_ws;
    void* args[] = {&p};
    hipError_t e = hipLaunchCooperativeKernel((const void*)fwd_megakernel, dim3(grid_blocks), dim3(512), args, LDS_BYTES, stream);
    if (e != hipSuccess) fprintf(stderr, "cooperative launch failed: %s (grid %d)\n", hipGetErrorString(e), grid_blocks);
}
```

```cpp
#define GSYNC() xcd_barrier(xbar)
#include <hip/hip_runtime.h>
#include <hip/hip_cooperative_groups.h>
#include <cstdint>
#include <cstdio>
namespace cg = cooperative_groups;

#define LAS __attribute__((address_space(3)))
typedef unsigned short bf16_t;
typedef short bf16x8 __attribute__((ext_vector_type(8)));
typedef float f32x4 __attribute__((ext_vector_type(4)));
typedef float f32x16 __attribute__((ext_vector_type(16)));
typedef unsigned u32x4 __attribute__((ext_vector_type(4)));
typedef unsigned u32x2 __attribute__((ext_vector_type(2)));
typedef float f32x2_t __attribute__((ext_vector_type(2)));
typedef __bf16 bf16x2_t __attribute__((ext_vector_type(2)));

constexpr int NB = 8, SEQ = 4096, DM = 2048, MT = NB * SEQ, DFF = 5632;
constexpr float LOG2E = 1.4426950408889634f;
constexpr float EPS = 1e-6f;
constexpr size_t MiB = 1u << 20;
constexpr size_t WS_WQK = 2 * MiB, WS_WV = 18 * MiB, WS_WOUT = 26 * MiB, WS_WMQ = 34 * MiB, WS_WMKV = 42 * MiB, WS_WMO = 58 * MiB,
                 WS_WGU = 66 * MiB, WS_WDN = 110 * MiB, WS_MEMN = 132 * MiB, WS_KVM = 140 * MiB, WS_WKT = 156 * MiB, WS_VWT = 188 * MiB,
                 WS_H = 224 * MiB, WS_QK = 352 * MiB, WS_VT = 608 * MiB, WS_AO = 736 * MiB, WS_MIX = 352 * MiB, WS_S = 480 * MiB,
                 WS_P = 608 * MiB, WS_MEMO = 672 * MiB, WS_F = 352 * MiB, WS_FO = 704 * MiB, WS_KD = 864 * MiB, WS_KS = 928 * MiB, WS_XR = 864 * MiB  , WS_PARK = 992 * MiB, WS_END = 1008 * MiB;

struct Params {
    const float* x; const float* mem; const float* w_in; const float* w_out; const float* rel_bias;
    const float* lq1; const float* lk1; const float* lq2; const float* lk2;
    const float* diff_gain; const float* sb_gain; const float* g_mix_pre; const float* g_mix_post;
    const float* w_mq; const float* w_mkv; const float* w_mo; const float* g_mem_kv; const float* g_mem_pre; const float* g_mem_post;
    const float* w_gu; const float* w_down; const float* g_ffn_pre; const float* g_ffn_post;
    float* out; unsigned char* ws;
};

__device__ __forceinline__ unsigned cvtpk(float lo, float hi) { f32x2_t v = {lo, hi}; bf16x2_t b = __builtin_convertvector(v, bf16x2_t); return __builtin_bit_cast(unsigned, b); }
__device__ __forceinline__ float bf_lo(unsigned u) { return __uint_as_float(u << 16); }
__device__ __forceinline__ float bf_hi(unsigned u) { return __uint_as_float(u & 0xffff0000u); }
__device__ __forceinline__ float wave_sum(float v) {
#pragma unroll
    for (int o = 1; o < 64; o <<= 1) v += __shfl_xor(v, o);
    return v;
}
__device__ __forceinline__ float wave_max(float v) {
#pragma unroll
    for (int o = 1; o < 64; o <<= 1) v = fmaxf(v, __shfl_xor(v, o));
    return v;
}
__device__ __forceinline__ float ex2(float v) { return __builtin_amdgcn_exp2f(v); }
__device__ __forceinline__ float lg2(float v) { return __builtin_amdgcn_logf(v); }

namespace pg8 {
constexpr int BM = 256, BK = 64, HALF = 128, HTB = HALF * BK * 2, STAGE_BYTES = 8 * HTB;
__device__ __forceinline__ int lds_byte(int r, int c) { const int st = (r >> 4) * 2 + (c >> 5), rr = r & 15, cc = c & 31, ob = rr * 64 + cc * 2; return st * 1024 + (ob ^ (((ob >> 9) & 1) << 5)); }
__device__ __forceinline__ void stage_rc(int b, int& R, int& C) { const int st = b / 1024, sb = b % 1024, swz = sb ^ (((sb >> 9) & 1) << 5); R = (st >> 1) * 16 + swz / 64; C = (st & 1) * 32 + (swz % 64) / 2; }
__device__ __forceinline__ int perm32(int rho) { const int n = rho >> 4, i = rho & 15; return 8 * (i >> 2) + 4 * n + (i & 3); }

struct GUnit { const char* A; const char* B; char* C; int SA, SR, SB, SX; float scale; };

struct GemmDesc {
    size_t A, B, C;
    int K, lda, ldb, ldc;
    int nM, nN;
    int kind, mode;
    int scale_kind;
    float scale;
    size_t a_tile, b_tile, b_batch, c_rt, c_ct;
    size_t a_b, a_h, a_t, b_b, b_h, b_t, c_b, c_h, c_t;
};

constexpr GemmDesc make_desc(int gi) {
    GemmDesc d{};
    d.scale = 1.0f; d.kind = 0; d.mode = 0; d.scale_kind = 0;
    switch (gi) {
    case 0:
        d.A = WS_H; d.B = WS_WQK; d.C = WS_QK;
        d.K = 2048; d.lda = 2048; d.ldb = 2048; d.ldc = 4096; d.nM = 128; d.nN = 16; d.scale_kind = 1;
        d.a_tile = (size_t)256 * 2048 * 2; d.b_tile = (size_t)256 * 2048 * 2; d.c_rt = (size_t)256 * 4096 * 2; d.c_ct = 512; break;
    case 1:
        d.A = WS_WV; d.B = WS_H; d.C = WS_VT;
        d.K = 2048; d.lda = 2048; d.ldb = 2048; d.ldc = MT; d.nM = 8; d.nN = 128; d.scale_kind = 2;
        d.a_tile = (size_t)256 * 2048 * 2; d.b_tile = (size_t)256 * 2048 * 2; d.c_rt = (size_t)256 * MT * 2; d.c_ct = 512; break;
    case 2:
        d.A = WS_MEMN; d.B = WS_WMKV; d.C = WS_KVM;
        d.K = 2048; d.lda = 2048; d.ldb = 2048; d.ldc = 4096; d.nM = 8; d.nN = 16;
        d.a_tile = (size_t)256 * 2048 * 2; d.b_tile = (size_t)256 * 2048 * 2; d.c_rt = (size_t)256 * 4096 * 2; d.c_ct = 512; break;
    case 3:
        d.A = WS_AO; d.B = WS_WOUT; d.C = WS_MIX;
        d.K = 2048; d.lda = 2048; d.ldb = 2048; d.ldc = 2048; d.nM = 128; d.nN = 8;
        d.a_tile = (size_t)256 * 2048 * 2; d.b_tile = (size_t)256 * 2048 * 2; d.c_rt = (size_t)256 * 2048 * 2; d.c_ct = 512; break;
    case 4:
        d.kind = 1; d.A = WS_KVM; d.B = WS_WMQ; d.C = WS_WKT;
        d.K = 512; d.lda = 4096; d.ldb = 2048; d.ldc = 2048; d.scale = 0.04419417382415922f * LOG2E;
        d.a_b = (size_t)256 * 4096 * 2; d.a_h = 1024; d.a_t = 0;
        d.b_b = 0; d.b_h = 1024; d.b_t = (size_t)256 * 2048 * 2;
        d.c_b = (size_t)1024 * 2048 * 2; d.c_h = (size_t)256 * 2048 * 2; d.c_t = 512; break;
    case 5:
        d.kind = 1; d.A = WS_WMO; d.B = WS_KVM + 4096; d.C = WS_VWT;
        d.K = 512; d.lda = 2048; d.ldb = 4096; d.ldc = 1024;
        d.a_b = 0; d.a_h = 1024; d.a_t = (size_t)256 * 2048 * 2;
        d.b_b = (size_t)256 * 4096 * 2; d.b_h = 1024; d.b_t = 0;
        d.c_b = (size_t)2048 * 1024 * 2; d.c_h = 512; d.c_t = (size_t)256 * 1024 * 2; break;
    case 6:
        d.A = WS_H; d.B = WS_WKT; d.C = WS_P; d.mode = 3;
        d.K = 2048; d.lda = 2048; d.ldb = 2048; d.ldc = 1024; d.nM = 128; d.nN = 4;
        d.a_tile = (size_t)256 * 2048 * 2; d.b_tile = (size_t)256 * 2048 * 2; d.b_batch = (size_t)1024 * 2048 * 2; d.c_rt = (size_t)256 * 1024 * 2; d.c_ct = 512; break;
    case 7:
        d.A = WS_P; d.B = WS_VWT; d.C = WS_MEMO;
        d.K = 1024; d.lda = 1024; d.ldb = 1024; d.ldc = 2048; d.nM = 128; d.nN = 8;
        d.a_tile = (size_t)256 * 1024 * 2; d.b_tile = (size_t)256 * 1024 * 2; d.b_batch = (size_t)2048 * 1024 * 2; d.c_rt = (size_t)256 * 2048 * 2; d.c_ct = 512; break;
    case 8:
        d.A = WS_H; d.B = WS_WGU; d.C = WS_F; d.mode = 2;
        d.K = 2048; d.lda = 2048; d.ldb = 2048; d.ldc = DFF; d.nM = 128; d.nN = 44;
        d.a_tile = (size_t)256 * 2048 * 2; d.b_tile = (size_t)256 * 2048 * 2; d.c_rt = (size_t)256 * DFF * 2; d.c_ct = 256; break;
    default:
        d.A = WS_F; d.B = WS_WDN; d.C = WS_FO;
        d.K = DFF; d.lda = DFF; d.ldb = DFF; d.ldc = 2048; d.nM = 128; d.nN = 8;
        d.a_tile = (size_t)256 * DFF * 2; d.b_tile = (size_t)256 * DFF * 2; d.c_rt = (size_t)256 * 2048 * 2; d.c_ct = 512; break;
    }
    return d;
}

template <int GI>
__device__ __forceinline__ bool sched_next(unsigned char* ws, int i, int G, int c, GUnit& u) {
    constexpr GemmDesc d = make_desc(GI);
    const int L = i * G + c;
    u.SA = 128 * d.ldc; u.SR = d.ldc; u.SB = 128; u.SX = 64; u.scale = d.scale;
    if (d.kind == 0) {
        constexpr int nwg = d.nM * d.nN;
        if (L >= nwg) return false;
        int wgid = L;
        { constexpr int q = nwg / 8, r = nwg % 8; const int xcd = wgid % 8, off = wgid / 8; wgid = (xcd < r ? xcd * (q + 1) : r * (q + 1) + (xcd - r) * q) + off; }
        constexpr int nig = 8 * d.nN; const int gid = wgid / nig, fm = gid * 8, gsz = (d.nM - fm) < 8 ? (d.nM - fm) : 8;
        const int pm = fm + ((wgid % nig) % gsz), pn = (wgid % nig) / gsz;
        u.A = (const char*)ws + d.A + (size_t)pm * d.a_tile;
        u.B = (const char*)ws + d.B + (size_t)(pm >> 4) * d.b_batch + (size_t)pn * d.b_tile;
        u.C = (char*)ws + d.C + (size_t)pm * d.c_rt + (size_t)pn * d.c_ct;
        if (d.scale_kind == 1) {
            u.scale = (pn < 4) ? 0.125f * LOG2E : ((pn >= 8 && pn < 12) ? 0.08838834764831845f * LOG2E : 1.0f);
            if (pn >= 4 && pn < 8) {
                u.C = (char*)ws + WS_KD + ((size_t)(4 * (pn - 4)) * MT + (size_t)pm * 256) * 64 * 2;
                u.SA = 128 * 64; u.SR = 64; u.SB = 2 * MT * 64; u.SX = MT * 64;
            } else if (pn >= 12) {
                u.C = (char*)ws + WS_KS + ((size_t)(2 * (pn - 12)) * MT + (size_t)pm * 256) * 128 * 2;
                u.SA = 128 * 128; u.SR = 128; u.SB = MT * 128; u.SX = 64;
            }
        } else if (d.scale_kind == 2) {
            u.C = (char*)ws + WS_VT + ((size_t)(2 * pm) * 512 + (size_t)(4 * pn)) * 8192 * 2;
            u.SA = 512 * 8192; u.SR = 64; u.SB = 2 * 8192; u.SX = 8192;
        }
        return true;
    } else {
        if (L >= 256) return false;
        const int z = L >> 3, t = L & 7, b = z >> 2, h = z & 3;
        u.A = (const char*)ws + d.A + (size_t)b * d.a_b + (size_t)h * d.a_h + (size_t)t * d.a_t;
        u.B = (const char*)ws + d.B + (size_t)b * d.b_b + (size_t)h * d.b_h + (size_t)t * d.b_t;
        u.C = (char*)ws + d.C + (size_t)b * d.c_b + (size_t)h * d.c_h + (size_t)t * d.c_t;
        return true;
    }
}

template <int mode>
__device__ __forceinline__ void epilogue(f32x4 (&acc)[2][2][4][2], const GUnit& u, int wr, int wc, int fr, int fq, LAS unsigned char* lds) {
    if (mode == 0) {
        bf16_t* base = (bf16_t*)u.C; const float sc = u.scale;
#pragma unroll
        for (int ai = 0; ai < 2; ++ai)
#pragma unroll
            for (int m = 0; m < 4; ++m) {
                bf16_t* rowp = base + (size_t)ai * u.SA + (size_t)(wr * 64 + m * 16 + fr) * u.SR + (wc >> 1) * u.SX + (wc & 1) * 32 + 8 * fq;
#pragma unroll
                for (int bj = 0; bj < 2; ++bj) {
                    const f32x4 v0 = acc[ai][bj][m][0] * sc, v1 = acc[ai][bj][m][1] * sc;
                    u32x4 w; w.x = cvtpk(v0[0], v0[1]); w.y = cvtpk(v0[2], v0[3]); w.z = cvtpk(v1[0], v1[1]); w.w = cvtpk(v1[2], v1[3]);
                    *(u32x4*)(rowp + (size_t)bj * u.SB) = w;
                }
            }
    } else if (mode == 1) {
        float* base = (float*)u.C; const float sc = u.scale;
#pragma unroll
        for (int ai = 0; ai < 2; ++ai)
#pragma unroll
            for (int m = 0; m < 4; ++m) {
                float* rowp = base + (size_t)ai * u.SA + (size_t)(wr * 64 + m * 16 + fr) * u.SR + (wc >> 1) * u.SX + (wc & 1) * 32 + 8 * fq;
#pragma unroll
                for (int bj = 0; bj < 2; ++bj) {
                    *(f32x4*)(rowp + (size_t)bj * u.SB) = acc[ai][bj][m][0] * sc;
                    *(f32x4*)(rowp + (size_t)bj * u.SB + 4) = acc[ai][bj][m][1] * sc;
                }
            }
    } else if (mode == 3) {
        LAS f32x2_t* X = (LAS f32x2_t*)(lds + 131200);
#pragma unroll
        for (int ai = 0; ai < 2; ++ai)
#pragma unroll
            for (int m = 0; m < 4; ++m) {
                float mx = -1e30f;
#pragma unroll
                for (int bj = 0; bj < 2; ++bj)
#pragma unroll
                    for (int n = 0; n < 2; ++n) { const f32x4 v = acc[ai][bj][m][n]; mx = fmaxf(mx, fmaxf(fmaxf(v[0], v[1]), fmaxf(v[2], v[3]))); }
                mx = fmaxf(mx, __shfl_xor(mx, 16)); mx = fmaxf(mx, __shfl_xor(mx, 32));
                float sum = 0.f;
#pragma unroll
                for (int bj = 0; bj < 2; ++bj)
#pragma unroll
                    for (int n = 0; n < 2; ++n) { f32x4 v = acc[ai][bj][m][n]; v[0] = ex2(v[0] - mx); v[1] = ex2(v[1] - mx); v[2] = ex2(v[2] - mx); v[3] = ex2(v[3] - mx);
                        acc[ai][bj][m][n] = v; sum += (v[0] + v[1]) + (v[2] + v[3]); }
                sum += __shfl_xor(sum, 16); sum += __shfl_xor(sum, 32);
                if (fq == 0) X[(ai * HALF + wr * 64 + m * 16 + fr) * 4 + wc] = (f32x2_t){mx, sum};
            }
        asm volatile("s_waitcnt lgkmcnt(0)" ::: "memory"); __builtin_amdgcn_s_barrier(); asm volatile("" ::: "memory");
        bf16_t* base = (bf16_t*)u.C;
#pragma unroll
        for (int ai = 0; ai < 2; ++ai)
#pragma unroll
            for (int m = 0; m < 4; ++m) {
                const int row = ai * HALF + wr * 64 + m * 16 + fr;
                const f32x2_t a0 = X[row * 4 + 0], a1 = X[row * 4 + 1], a2 = X[row * 4 + 2], a3 = X[row * 4 + 3];
                const float M = fmaxf(fmaxf(a0.x, a1.x), fmaxf(a2.x, a3.x));
                const float tot = (a0.y * ex2(a0.x - M) + a1.y * ex2(a1.x - M)) + (a2.y * ex2(a2.x - M) + a3.y * ex2(a3.x - M));
                const float own = (wc == 0) ? a0.x : (wc == 1) ? a1.x : (wc == 2) ? a2.x : a3.x;
                const float f = ex2(own - M) / tot;
                bf16_t* rowp = base + (size_t)ai * u.SA + (size_t)(wr * 64 + m * 16 + fr) * u.SR + (wc >> 1) * u.SX + (wc & 1) * 32 + 8 * fq;
#pragma unroll
                for (int bj = 0; bj < 2; ++bj) {
                    const f32x4 v0 = acc[ai][bj][m][0] * f, v1 = acc[ai][bj][m][1] * f;
                    u32x4 w; w.x = cvtpk(v0[0], v0[1]); w.y = cvtpk(v0[2], v0[3]); w.z = cvtpk(v1[0], v1[1]); w.w = cvtpk(v1[2], v1[3]);
                    *(u32x4*)(rowp + (size_t)bj * u.SB) = w;
                }
            }
    } else {
        bf16_t* base = (bf16_t*)u.C;
#pragma unroll
        for (int ai = 0; ai < 2; ++ai)
#pragma unroll
            for (int m = 0; m < 4; ++m) {
                bf16_t* rowp = base + (size_t)ai * u.SA + (size_t)(wr * 64 + m * 16 + fr) * u.SR + (wc >> 1) * u.SX + (wc & 1) * 32 + 8 * fq;
                float y[8];
#pragma unroll
                for (int n = 0; n < 2; ++n)
#pragma unroll
                    for (int j = 0; j < 4; ++j) {
                        const float g = acc[ai][0][m][n][j], up = acc[ai][1][m][n][j];
                        y[n * 4 + j] = g * __builtin_amdgcn_rcpf(1.0f + ex2(-g * LOG2E)) * up;
                    }
                u32x4 w; w.x = cvtpk(y[0], y[1]); w.y = cvtpk(y[2], y[3]); w.z = cvtpk(y[4], y[5]); w.w = cvtpk(y[6], y[7]);
                *(u32x4*)rowp = w;
            }
    }
}

template <int GI>
__device__ __forceinline__ void gemm_phase(LAS unsigned char* lds, unsigned char* ws, int G, int cblk) {
    constexpr GemmDesc g = make_desc(GI);
    int tid_ = threadIdx.x; asm volatile("" : "+v"(tid_));
    const int tid = tid_, wid = __builtin_amdgcn_readfirstlane(tid >> 6), lane = tid & 63, wr = wid >> 2, wc = wid & 3, fr = lane & 15, fq = lane >> 4;
    constexpr int K = g.K, nt = K / BK, lda = g.lda, ldb = g.ldb;
    unsigned voffA[2], voffB[2];
#pragma unroll
    for (int i = 0; i < 2; ++i) { int R, C; stage_rc(tid * 16 + i * 8192, R, C); const int Rb = (R & ~31) + perm32(R & 31);
        voffA[i] = (unsigned)(R * lda + C) * 2u; voffB[i] = (unsigned)(Rb * ldb + C) * 2u; }
    const size_t kstep = (size_t)(BK * 2);
    const size_t hstepA = (size_t)HALF * lda * 2, hstepB = (size_t)HALF * ldb * 2;
    const unsigned ldsw = (unsigned)wid * 1024u;
    const int aoff = lds_byte(wr * 64 + fr, fq * 8), boff = lds_byte(wc * 32 + fr, fq * 8);
#define PG8_SA(b, h) (((b) * 2 + (h)) * HTB)
#define PG8_SB(b, h) ((4 + (b) * 2 + (h)) * HTB)
#define PG8_STAGE(bufoff, gbase, voff) do { _Pragma("unroll") for (int _i = 0; _i < 2; ++_i) \
        __builtin_amdgcn_global_load_lds((const unsigned*)((const char*)(gbase) + (voff)[_i]), (LAS unsigned*)(lds + (bufoff) + ldsw + _i * 8192), 16, 0, 0); } while (0)
#define PG8_LDA(dst, b, h) do { _Pragma("unroll") for (int m = 0; m < 4; ++m) _Pragma("unroll") for (int k = 0; k < 2; ++k) dst[m][k] = *(const LAS bf16x8*)(lds + PG8_SA(b, h) + aoff + m * 2048 + k * 1024); } while (0)
#define PG8_LDB(dst, b, h) do { _Pragma("unroll") for (int n = 0; n < 2; ++n) _Pragma("unroll") for (int k = 0; k < 2; ++k) dst[n][k] = *(const LAS bf16x8*)(lds + PG8_SB(b, h) + boff + n * 2048 + k * 1024); } while (0)
#define PG8_MMA(ai, bj, At, Bt) do { __builtin_amdgcn_s_setprio(1); _Pragma("unroll") for (int m = 0; m < 4; ++m) _Pragma("unroll") for (int n = 0; n < 2; ++n) _Pragma("unroll") for (int k = 0; k < 2; ++k) \
        acc[ai][bj][m][n] = __builtin_amdgcn_mfma_f32_16x16x32_bf16(Bt[n][k], At[m][k], acc[ai][bj][m][n], 0, 0, 0); __builtin_amdgcn_s_setprio(0); } while (0)
#define PG8_WAIT_V(n) asm volatile("s_waitcnt vmcnt(" #n ")" ::: "memory")
#define PG8_WAIT_L(n) asm volatile("s_waitcnt lgkmcnt(" #n ")" ::: "memory")
#define PG8_BAR __builtin_amdgcn_s_barrier()
#define PG8_SCHED __builtin_amdgcn_sched_barrier(0)
    GUnit cur, nxt; int ui = 0;
    if (!sched_next<GI>(ws, 0, G, cblk, cur)) return;
    f32x4 acc[2][2][4][2];
#pragma unroll
    for (int a = 0; a < 2; ++a)
#pragma unroll
        for (int b = 0; b < 2; ++b)
#pragma unroll
            for (int m = 0; m < 4; ++m)
#pragma unroll
                for (int n = 0; n < 2; ++n) acc[a][b][m][n] = (f32x4){0.f, 0.f, 0.f, 0.f};
    bf16x8 At[4][2], B0[2][2], B1[2][2];
    const char* cA = cur.A; const char* cB = cur.B;
    PG8_STAGE(PG8_SB(0, 0), cB, voffB); PG8_STAGE(PG8_SB(0, 1), cB + hstepB, voffB); PG8_STAGE(PG8_SA(0, 0), cA, voffA); PG8_STAGE(PG8_SA(0, 1), cA + hstepA, voffA);
    if (wr == 1) PG8_BAR;
    PG8_WAIT_V(2); PG8_BAR;
    PG8_STAGE(PG8_SB(1, 0), cB + kstep, voffB); PG8_STAGE(PG8_SA(1, 0), cA + kstep, voffA); PG8_STAGE(PG8_SB(1, 1), cB + hstepB + kstep, voffB);
    PG8_WAIT_V(6); PG8_BAR;
    for (;;) {
        const bool has_next = sched_next<GI>(ws, ui + 1, G, cblk, nxt);
        const char* nA = has_next ? nxt.A : cA; const char* nB = has_next ? nxt.B : cB;
        for (int t = 0; t < nt; t += 2) {
            const bool last = (t == nt - 2);
            const char* a1 = cA + (size_t)(t + 1) * kstep;
            const char* a2 = last ? nA : cA + (size_t)(t + 2) * kstep; const char* b2 = last ? nB : cB + (size_t)(t + 2) * kstep;
            const char* a3 = a2 + kstep; const char* b3 = b2 + kstep;
            PG8_LDB(B0, 0, 0); PG8_LDB(B1, 0, 1); PG8_SCHED; PG8_LDA(At, 0, 0); PG8_STAGE(PG8_SA(1, 1), a1 + hstepA, voffA);
            PG8_WAIT_V(8); PG8_WAIT_L(0); PG8_BAR; PG8_MMA(0, 0, At, B0); PG8_MMA(0, 1, At, B1); PG8_BAR; PG8_SCHED;
            PG8_LDA(At, 0, 1); PG8_STAGE(PG8_SB(0, 0), b2, voffB); PG8_STAGE(PG8_SB(0, 1), b2 + hstepB, voffB); PG8_STAGE(PG8_SA(0, 0), a2, voffA);
            PG8_WAIT_V(8); PG8_WAIT_L(0); PG8_BAR; PG8_MMA(1, 0, At, B0); PG8_MMA(1, 1, At, B1); PG8_BAR; PG8_SCHED;
            PG8_LDB(B0, 1, 0); PG8_LDB(B1, 1, 1); PG8_SCHED; PG8_LDA(At, 1, 0); PG8_STAGE(PG8_SA(0, 1), a2 + hstepA, voffA);
            PG8_WAIT_V(8); PG8_WAIT_L(0); PG8_BAR; PG8_MMA(0, 0, At, B0); PG8_MMA(0, 1, At, B1); PG8_BAR; PG8_SCHED;
            PG8_LDA(At, 1, 1); PG8_STAGE(PG8_SB(1, 0), b3, voffB); PG8_STAGE(PG8_SB(1, 1), b3 + hstepB, voffB); PG8_STAGE(PG8_SA(1, 0), a3, voffA);
            PG8_WAIT_V(8); PG8_WAIT_L(0); PG8_BAR; PG8_MMA(1, 0, At, B0); PG8_MMA(1, 1, At, B1); PG8_BAR; PG8_SCHED;
        }
        if (wr == 0) PG8_BAR;
        epilogue<g.mode>(acc, cur, wr, wc, fr, fq, lds);
        if (!has_next) break;
#pragma unroll
        for (int a = 0; a < 2; ++a)
#pragma unroll
            for (int b = 0; b < 2; ++b)
#pragma unroll
                for (int m = 0; m < 4; ++m)
#pragma unroll
                    for (int n = 0; n < 2; ++n) acc[a][b][m][n] = (f32x4){0.f, 0.f, 0.f, 0.f};
        cur = nxt; cA = nA; cB = nB; ++ui;
        if (wr == 1) PG8_BAR;
    }
    PG8_WAIT_V(0);
    PG8_BAR;
#undef PG8_SA
#undef PG8_SB
#undef PG8_STAGE
#undef PG8_LDA
#undef PG8_LDB
#undef PG8_MMA
#undef PG8_WAIT_V
#undef PG8_WAIT_L
#undef PG8_BAR
#undef PG8_SCHED
}
}

#define XB_TMO      128
#define XB_XCNT(j)  (256  + 64 * (j))
#define XB_XSUB(j)  (1280 + 64 * (j))
#define XB_XGEN(j)  (2304 + 64 * (j))
#define XB_TOP      3328
#define XB_TOPGEN   3392
#define XCD_BAR_WORDS 3456
#define XB_SPIN_CAP (1u << 18)

__device__ __forceinline__ unsigned xb_ld(unsigned* p)              { return __hip_atomic_load(p, __ATOMIC_RELAXED, __HIP_MEMORY_SCOPE_AGENT); }
__device__ __forceinline__ unsigned xb_add(unsigned* p, unsigned v) { return __hip_atomic_fetch_add(p, v, __ATOMIC_RELAXED, __HIP_MEMORY_SCOPE_AGENT); }
__device__ __forceinline__ unsigned xb_xcc_id() { return (unsigned)__builtin_amdgcn_s_getreg((3 << 11) | 20) & 0xFu; }
#define XB_SPIN(cond, bar) do { unsigned _sp = 0; while (cond) { __builtin_amdgcn_s_sleep(1); \
    if ((++_sp & 255u) == 0u) { if (xb_ld(&(bar)[XB_TMO])) break; if (_sp > XB_SPIN_CAP) { atomicAdd(&(bar)[XB_TMO], 1u); break; } } } } while (0)

struct XcdBarrier {
    unsigned* bar; unsigned x;
    volatile LAS unsigned* st;
};

__device__ __forceinline__ XcdBarrier xcd_barrier_post(unsigned* bar, volatile LAS unsigned* st) {
    XcdBarrier b; b.bar = bar; b.x = xb_xcc_id(); b.st = st;
    if (threadIdx.x == 0) (void)xb_add(&bar[XB_XCNT(b.x)], 1u);
    return b;
}
__device__ __forceinline__ void xcd_barrier_complete(unsigned* bar, unsigned x, unsigned& nloc, unsigned& nx) {
    const unsigned G = gridDim.x * gridDim.y * gridDim.z;
    unsigned sum, cnt, mine, sp = 0u;
    for (;;) {
        sum = 0u; cnt = 0u; mine = 0u;
#pragma unroll
        for (unsigned j = 0; j < 16; ++j) { const unsigned c = xb_ld(&bar[XB_XCNT(j)]); sum += c; cnt += (c > 0u) ? 1u : 0u; mine = (j == x) ? c : mine; }
        if (sum == G) break;
        __builtin_amdgcn_s_sleep(1);
        if ((++sp & 255u) == 0u) { if (xb_ld(&bar[XB_TMO])) break; if (sp > XB_SPIN_CAP) { atomicAdd(&bar[XB_TMO], 1u); break; } }
    }
    nloc = mine > 0u ? mine : 1u; nx = cnt > 0u ? cnt : 1u;
}

__device__ __forceinline__ void xcd_barrier(const XcdBarrier& b) {
    asm volatile("s_waitcnt vmcnt(0)" ::: "memory");
    __syncthreads();
    if (threadIdx.x == 0) {
        unsigned* bar = b.bar;
        __builtin_amdgcn_s_waitcnt(0);
        unsigned nloc = b.st[0], nx = b.st[1];
        if (nloc == 0u) { xcd_barrier_complete(bar, b.x, nloc, nx); b.st[0] = nloc; b.st[1] = nx; }
        const unsigned old = xb_add(&bar[XB_XSUB(b.x)], 1u);
        const unsigned gen = old / nloc;
        if (old + 1u == (gen + 1u) * nloc) {
            __builtin_amdgcn_fence(__ATOMIC_RELEASE, "agent");
            asm volatile("s_waitcnt vmcnt(0)" ::: "memory");
            const unsigned og = xb_add(&bar[XB_TOP], 1u);
            const unsigned tg = og / nx;
            if (og + 1u == (tg + 1u) * nx) xb_add(&bar[XB_TOPGEN], 1u);
            else XB_SPIN(xb_ld(&bar[XB_TOPGEN]) == tg, bar);
            __builtin_amdgcn_fence(__ATOMIC_ACQUIRE, "agent");
            xb_add(&bar[XB_XGEN(b.x)], 1u);
            asm volatile("s_waitcnt vmcnt(0)" ::: "memory");
        } else {
            XB_SPIN(xb_ld(&bar[XB_XGEN(b.x)]) == gen, bar);
            __builtin_amdgcn_fence(__ATOMIC_ACQUIRE, "agent");
            asm volatile("s_waitcnt vmcnt(0)" ::: "memory");
        }
    }
    __syncthreads();
}

__device__ __forceinline__ void tr_item(const float* W, int N, int K, int k0, int n0, bf16_t* dst, LAS float* scr, int lane) {
#pragma unroll 8
    for (int i = 0; i < 32; ++i) { const int kk = 2 * i + (lane >> 5); scr[kk * 33 + (lane & 31)] = W[(size_t)(k0 + kk) * N + n0 + (lane & 31)]; }
    asm volatile("s_waitcnt lgkmcnt(0)" ::: "memory");
    const int c = lane & 7;
#pragma unroll
    for (int j = 0; j < 4; ++j) { const int n = (lane >> 3) + 8 * j; const LAS float* s = scr + (8 * c) * 33 + n;
        u32x4 o; o.x = cvtpk(s[0 * 33], s[1 * 33]); o.y = cvtpk(s[2 * 33], s[3 * 33]); o.z = cvtpk(s[4 * 33], s[5 * 33]); o.w = cvtpk(s[6 * 33], s[7 * 33]);
        *(u32x4*)(dst + (size_t)n * K + k0 + 8 * c) = o; }
    asm volatile("s_waitcnt lgkmcnt(0)" ::: "memory");
}

__device__ __forceinline__ void rms_row_bf16(const float* xrow, const float* g, bf16_t* orow, int lane) {
    const f32x4* xr = (const f32x4*)xrow + lane;
    f32x4 v[8]; float s = 0.f;
#pragma unroll
    for (int j = 0; j < 8; ++j) { v[j] = xr[64 * j]; s += (v[j].x * v[j].x + v[j].y * v[j].y) + (v[j].z * v[j].z + v[j].w * v[j].w); }
    const float r = 1.0f / sqrtf(wave_sum(s) * (1.0f / DM) + EPS);
    const f32x4* gr = (const f32x4*)g + lane;
    u32x2* o8 = (u32x2*)orow + lane;
#pragma unroll
    for (int j = 0; j < 8; ++j) { const f32x4 gv = gr[64 * j]; u32x2 w; w.x = cvtpk(v[j].x * r * gv.x, v[j].y * r * gv.y); w.y = cvtpk(v[j].z * r * gv.z, v[j].w * r * gv.w); o8[64 * j] = w; }
}

__device__ __forceinline__ void prologue(const Params& p, LAS unsigned char* lds, int G, int blk) {
    const int tid = threadIdx.x, lane = tid & 63, wave = __builtin_amdgcn_readfirstlane(tid >> 6);
    LAS float* scr = (LAS float*)(lds + wave * 16384);
    const int gw = blk * 8 + wave, NGW = G * 8;
    unsigned char* ws = p.ws;
    bf16_t* Wqk = (bf16_t*)(ws + WS_WQK); bf16_t* Wv = (bf16_t*)(ws + WS_WV); bf16_t* Wout = (bf16_t*)(ws + WS_WOUT);
    bf16_t* Wmkv = (bf16_t*)(ws + WS_WMKV); bf16_t* Wmo = (bf16_t*)(ws + WS_WMO); bf16_t* Wgu = (bf16_t*)(ws + WS_WGU); bf16_t* Wdn = (bf16_t*)(ws + WS_WDN);
    constexpr int I0 = 32 * 192, I1 = 32 * 64, I2 = 32 * 128, I3 = 32 * 64, I4 = 32 * 352, I5 = 88 * 64;
    constexpr int NIT = I0 + I1 + I2 + I3 + I4 + I5;
    for (int it = gw; it < NIT; it += NGW) {
        int r = it;
        if (r < I0) { const int kb = r / 192, nb = r % 192, n0 = nb * 32; bf16_t* dst;
            if (n0 < 2048) dst = Wqk + (size_t)n0 * 2048;
            else if (n0 < 3072) dst = Wv + (size_t)(n0 - 2048) * 2048;
            else if (n0 < 5120) dst = Wqk + (size_t)(2048 + n0 - 3072) * 2048;
            else dst = Wv + (size_t)(1024 + n0 - 5120) * 2048;
            tr_item(p.w_in, 6144, 2048, kb * 64, n0, dst, scr, lane); continue; }
        r -= I0;
        if (r < I1) { const int kb = r / 64, nb = r % 64; tr_item(p.w_out, 2048, 2048, kb * 64, nb * 32, Wout + (size_t)(nb * 32) * 2048, scr, lane); continue; }
        r -= I1;
        if (r < I2) { const int kb = r / 128, nb = r % 128; tr_item(p.w_mkv, 4096, 2048, kb * 64, nb * 32, Wmkv + (size_t)(nb * 32) * 2048, scr, lane); continue; }
        r -= I2;
        if (r < I3) { const int kb = r / 64, nb = r % 64; tr_item(p.w_mo, 2048, 2048, kb * 64, nb * 32, Wmo + (size_t)(nb * 32) * 2048, scr, lane); continue; }
        r -= I3;
        if (r < I4) { const int kb = r / 352, nb = r % 352, n0 = nb * 32; int drow;
            if (n0 < DFF) drow = 256 * (n0 / 128) + (n0 % 128); else { const int c2 = n0 - DFF; drow = 256 * (c2 / 128) + 128 + (c2 % 128); }
            tr_item(p.w_gu, 2 * DFF, 2048, kb * 64, n0, Wgu + (size_t)drow * 2048, scr, lane); continue; }
        r -= I4;
        { const int kb = r / 64, nb = r % 64; tr_item(p.w_down, 2048, DFF, kb * 64, nb * 32, Wdn + (size_t)(nb * 32) * DFF, scr, lane); }
    }
    { bf16_t* Wmq = (bf16_t*)(ws + WS_WMQ); const int gt = blk * 512 + tid, NGT = G * 512;
      for (int i = gt; i < 2048 * 2048 / 4; i += NGT) { const f32x4 v = ((const f32x4*)p.w_mq)[i]; u32x2 w; w.x = cvtpk(v.x, v.y); w.y = cvtpk(v.z, v.w); ((u32x2*)Wmq)[i] = w; } }
    bf16_t* H = (bf16_t*)(ws + WS_H); bf16_t* memn = (bf16_t*)(ws + WS_MEMN);
    for (int m = gw; m < MT; m += NGW) rms_row_bf16(p.x + (size_t)m * DM, p.g_mix_pre, H + (size_t)m * DM, lane);
    for (int m = gw; m < NB * 256; m += NGW) rms_row_bf16(p.mem + (size_t)m * DM, p.g_mem_kv, memn + (size_t)m * DM, lane);
}

template <bool HAS_H, bool XIN_BF, bool XOUT_BF>
__device__ __forceinline__ void row_pass(const bf16_t* y, const void* xin, void* xout, const float* g_post, const float* g_pre, bf16_t* hout, int G, int blk) {
    const int tid = threadIdx.x, lane = tid & 63, wave = tid >> 6;
    const int gw = blk * 8 + wave, NGW = G * 8;
    for (int row = gw; row < MT; row += NGW) {
        const u32x2* yr = (const u32x2*)(y + (size_t)row * DM) + lane;
        const f32x4* xr = (const f32x4*)((const float*)xin + (size_t)row * DM) + lane;
        const u32x2* xrb = (const u32x2*)((const bf16_t*)xin + (size_t)row * DM) + lane;
        f32x4 yv[8], xv[8]; float s = 0.f;
#pragma unroll
        for (int j = 0; j < 8; ++j) { const u32x2 w = yr[64 * j]; yv[j] = (f32x4){bf_lo(w.x), bf_hi(w.x), bf_lo(w.y), bf_hi(w.y)};
            if (XIN_BF) { const u32x2 xw = xrb[64 * j]; xv[j] = (f32x4){bf_lo(xw.x), bf_hi(xw.x), bf_lo(xw.y), bf_hi(xw.y)}; } else xv[j] = xr[64 * j];
            s += (yv[j].x * yv[j].x + yv[j].y * yv[j].y) + (yv[j].z * yv[j].z + yv[j].w * yv[j].w); }
        const float r = 1.0f / sqrtf(wave_sum(s) * (1.0f / DM) + EPS);
        const f32x4* gp = (const f32x4*)g_post + lane;
        f32x4* xo = (f32x4*)((float*)xout + (size_t)row * DM) + lane;
        u32x2* xob = (u32x2*)((bf16_t*)xout + (size_t)row * DM) + lane;
        float s1 = 0.f;
#pragma unroll
        for (int j = 0; j < 8; ++j) { const f32x4 gv = gp[64 * j]; xv[j] = xv[j] + yv[j] * r * gv;
            if (XOUT_BF) { u32x2 w; w.x = cvtpk(xv[j].x, xv[j].y); w.y = cvtpk(xv[j].z, xv[j].w); xob[64 * j] = w; } else xo[64 * j] = xv[j];
            s1 += (xv[j].x * xv[j].x + xv[j].y * xv[j].y) + (xv[j].z * xv[j].z + xv[j].w * xv[j].w); }
        if (HAS_H) {
            const float r1 = 1.0f / sqrtf(wave_sum(s1) * (1.0f / DM) + EPS);
            const f32x4* gq = (const f32x4*)g_pre + lane;
            u32x2* ho = (u32x2*)(hout + (size_t)row * DM) + lane;
#pragma unroll
            for (int j = 0; j < 8; ++j) { const f32x4 gv = gq[64 * j]; u32x2 w; w.x = cvtpk(xv[j].x * r1 * gv.x, xv[j].y * r1 * gv.y); w.y = cvtpk(xv[j].z * r1 * gv.z, xv[j].w * r1 * gv.w); ho[64 * j] = w; }
        }
    }
}

__device__ __forceinline__ void softmax_pass(const float* S, bf16_t* P, int G, int blk) {
    const int tid = threadIdx.x, lane = tid & 63, wave = tid >> 6;
    const int gw = blk * 8 + wave, NGW = G * 8;
    for (int row = gw; row < MT; row += NGW) {
        const f32x4* sr = (const f32x4*)(S + (size_t)row * 1024) + lane;
        u32x2* pr = (u32x2*)(P + (size_t)row * 1024) + lane;
        f32x4 v[4];
#pragma unroll
        for (int h = 0; h < 4; ++h) v[h] = sr[64 * h];
#pragma unroll
        for (int h = 0; h < 4; ++h) {
            const float mx = wave_max(fmaxf(fmaxf(v[h].x, v[h].y), fmaxf(v[h].z, v[h].w)));
            f32x4 e; e.x = ex2(v[h].x - mx); e.y = ex2(v[h].y - mx); e.z = ex2(v[h].z - mx); e.w = ex2(v[h].w - mx);
            const float inv = 1.0f / wave_sum((e.x + e.y) + (e.z + e.w));
            u32x2 w; w.x = cvtpk(e.x * inv, e.y * inv); w.y = cvtpk(e.z * inv, e.w * inv); pr[64 * h] = w;
        }
    }
}

#ifndef PROBE_DIFF_REPS
#define PROBE_DIFF_REPS 1
#endif
#ifndef PROBE_SB_REPS
#define PROBE_SB_REPS 1
#endif
constexpr int A_KBUF = 16384, A_VBUF = 16384, A_KOFF = 0, A_VOFF = 2 * A_KBUF, A_TAB = A_VOFF + 2 * A_VBUF, A_FLAG = A_TAB + 1024;
#define MFMA32(a, b, c) __builtin_amdgcn_mfma_f32_32x32x16_bf16((a), (b), (c), 0, 0, 0)
#define SCHEDB() __builtin_amdgcn_sched_barrier(0)
__device__ __forceinline__ int crow(int r, int h) { return (r & 3) + 8 * (r >> 2) + 4 * h; }

template <int KD>
__device__ __forceinline__ void tile_dma(const bf16_t* Kg, const bf16_t* Vg, LAS unsigned char* kb, LAS unsigned char* vb, int wid, int lane) {
    if (KD == 128) {
#pragma unroll
        for (int i = 0; i < 2; ++i) {
            const int kc = wid * 2 + i, rho = 4 * kc + (lane >> 4), x = lane & 15, i5 = rho & 31;
            const int key = (rho & 32) + 16 * ((i5 >> 2) & 1) + 8 * (i5 >> 4) + 4 * ((i5 >> 3) & 1) + (i5 & 3);
            const bf16_t* src = Kg + (size_t)key * KD + ((x ^ (rho & 15)) * 8);
            __builtin_amdgcn_global_load_lds((const unsigned*)src, (LAS unsigned*)(kb + kc * 1024), 16, 0, 0);
        }
    } else {
        const int kc = wid, rho = 8 * kc + (lane >> 3), x = lane & 7, i5 = rho & 31;
        const int key = (rho & 32) + 16 * ((i5 >> 2) & 1) + 8 * (i5 >> 4) + 4 * ((i5 >> 3) & 1) + (i5 & 3);
        const bf16_t* src = Kg + (size_t)key * KD + ((x ^ ((rho >> 1) & 7)) * 8);
        __builtin_amdgcn_global_load_lds((const unsigned*)src, (LAS unsigned*)(kb + kc * 1024), 16, 0, 0);
    }
#pragma unroll
    for (int i = 0; i < 2; ++i) {
        const int vc = wid * 2 + i, rho = 8 * vc + (lane >> 3), x = lane & 7;
        const bf16_t* src = Vg + (size_t)rho * 64 + ((x ^ ((rho >> 1) & 7)) * 8);
        __builtin_amdgcn_global_load_lds((const unsigned*)src, (LAS unsigned*)(vb + vc * 1024), 16, 0, 0);
    }
}
__device__ __forceinline__ bf16x8 pack8(const f32x16& s, int o) {
    u32x4 w; w.x = cvtpk(s[o], s[o + 1]); w.y = cvtpk(s[o + 2], s[o + 3]); w.z = cvtpk(s[o + 4], s[o + 5]); w.w = cvtpk(s[o + 6], s[o + 7]);
    return __builtin_bit_cast(bf16x8, w);
}
__device__ __forceinline__ void pv_acc(f32x16 (&O)[4], const f32x16& s0, const f32x16& s1, const LAS unsigned char* vbase, int xv) {
#pragma unroll
    for (int g = 0; g < 4; ++g) {
        const int kbk = g >> 1, s = g & 1;
        const int co = ((4 * kbk + s) ^ xv) << 4;
        bf16x8 vf[4];
#pragma unroll
        for (int db = 0; db < 4; ++db) vf[db] = *(const LAS bf16x8*)(vbase + db * 4096 + co);
        const bf16x8 pf = pack8(kbk ? s1 : s0, 8 * s);
#pragma unroll
        for (int db = 0; db < 4; ++db) O[db] = MFMA32(pf, vf[db], O[db]);
        SCHEDB();
    }
}
template <int NKS, int ROWB>
__device__ __forceinline__ void qk_tile(f32x16& s0, f32x16& s1, const LAS unsigned char* kb, int xk, const bf16x8* qf) {
    bf16x8 a[2][2];
    { const int co = (0 ^ xk) << 4; a[0][0] = *(const LAS bf16x8*)(kb + co); a[0][1] = *(const LAS bf16x8*)(kb + 32 * ROWB + co); }
#pragma unroll
    for (int ks = 0; ks < NKS; ++ks) {
        if (ks + 1 < NKS) { const int co = ((2 * (ks + 1)) ^ xk) << 4; a[(ks + 1) & 1][0] = *(const LAS bf16x8*)(kb + co); a[(ks + 1) & 1][1] = *(const LAS bf16x8*)(kb + 32 * ROWB + co); }
        s0 = MFMA32(a[ks & 1][0], qf[ks], s0); s1 = MFMA32(a[ks & 1][1], qf[ks], s1);
        SCHEDB();
    }
}

__device__ __forceinline__ void smax_update(f32x16& s0, f32x16& s1, float& m, float& l, f32x16 (&O)[4], int hh) {
    float mx = fmaxf(s0[0], s1[0]);
#pragma unroll
    for (int r = 1; r < 16; ++r) mx = fmaxf(mx, fmaxf(s0[r], s1[r]));
    mx = fmaxf(mx, __shfl_xor(mx, 32));
    if (__any(mx > m + 8.0f)) {
        const float mn = fmaxf(m, mx);
        const float alpha = ex2(m - mn);
        l *= alpha; m = mn;
        int hl = hh; asm volatile("" : "+v"(hl));
#pragma unroll
        for (int r = 0; r < 16; ++r) { const float a = __shfl(alpha, crow(r, hl));
#pragma unroll
            for (int db = 0; db < 4; ++db) O[db][r] *= a; }
    }
    float sum = 0.f;
#pragma unroll
    for (int r = 0; r < 16; ++r) { s0[r] = ex2(s0[r] - m); s1[r] = ex2(s1[r] - m); sum += s0[r] + s1[r]; }
    l += sum;
}

#define MX3(a, b, c) __builtin_fmaxf(__builtin_fmaxf((a), (b)), (c))
__device__ __forceinline__ void diff_unit(const Params& p, LAS unsigned char* lds, int b, int h, int qb, float lam) {
    int tid_ = threadIdx.x; asm volatile("" : "+v"(tid_));
    const int tid = tid_, lane = tid & 63, wid = __builtin_amdgcn_readfirstlane(tid >> 6), c = lane & 31, hh = lane >> 5;
    const bf16_t* QK = (const bf16_t*)(p.ws + WS_QK); const bf16_t* VT = (const bf16_t*)(p.ws + WS_VT); bf16_t* AO = (bf16_t*)(p.ws + WS_AO);
    const size_t rowbase = (size_t)b * SEQ;
    const int q0 = qb * 256 + wid * 32, mylast = q0 >> 6, NT = 4 * qb + 4;
    const int xk = ((c >> 1) & 7) ^ hh, xv = ((c >> 1) & 7) ^ (2 * hh);
    LAS float* tab = (LAS float*)(lds + A_TAB);
    if (tid < 256) { const int d = tid - 64, n = d < 0 ? -d : d; int bk = (n < 8) ? n : min(15, 2 + (31 - __clz(n * n))); if (d < 0) bk += 16;
        tab[tid] = (p.rel_bias[bk * 8 + h] - p.rel_bias[15 * 8 + h]) * LOG2E; }
    const bf16_t* Vg0 = VT + ((size_t)h * 512 + (size_t)b * 64) * 8192;
    unsigned* park = (unsigned*)(p.ws + WS_PARK) + ((size_t)(blockIdx.x * 8 + wid) * 32) * 64 + lane;
    const bf16x8 ones = (bf16x8){0x3f80, 0x3f80, 0x3f80, 0x3f80, 0x3f80, 0x3f80, 0x3f80, 0x3f80};
    f32x16 O[4];
#pragma unroll
    for (int mp = 0; mp < 2; ++mp) {
        const bf16_t* Kg0 = (const bf16_t*)(p.ws + WS_KD) + ((size_t)(2 * h + mp) * MT + rowbase) * 64;
        tile_dma<64>(Kg0, Vg0, lds + A_KOFF, lds + A_VOFF, wid, lane);
        const bf16_t* qp = QK + (rowbase + q0 + c) * 4096 + h * 128 + 64 * mp + hh * 8;
        bf16x8 qf[4];
#pragma unroll
        for (int ks = 0; ks < 4; ++ks) qf[ks] = *(const bf16x8*)(qp + 16 * ks);
#pragma unroll
        for (int db = 0; db < 4; ++db) O[db] = (f32x16){};
        f32x16 L = (f32x16){};
        f32x16 negm = (f32x16){};
        float m = 0.f;
        asm volatile("s_waitcnt vmcnt(0)" ::: "memory");
        __syncthreads();
        for (int jt = 0; jt < NT; ++jt) {
            const int cur = jt & 1;
            if (jt + 1 < NT) tile_dma<64>(Kg0 + (size_t)(jt + 1) * 4096, Vg0 + (size_t)(jt + 1) * 8192, lds + A_KOFF + (cur ^ 1) * A_KBUF, lds + A_VOFF + (cur ^ 1) * A_VBUF, wid, lane);
            if (jt <= mylast) {
                const LAS unsigned char* kb = lds + A_KOFF + cur * A_KBUF + c * 128;
                const LAS unsigned char* vb = lds + A_VOFF + cur * A_VBUF + c * 128;
                f32x16 s0, s1;
                {
                    bf16x8 a[2][2];
                    { const int co = (0 ^ xk) << 4; a[0][0] = *(const LAS bf16x8*)(kb + co); a[0][1] = *(const LAS bf16x8*)(kb + 4096 + co); }
#pragma unroll
                    for (int ks = 0; ks < 4; ++ks) {
                        if (ks + 1 < 4) { const int co = ((2 * (ks + 1)) ^ xk) << 4; a[(ks + 1) & 1][0] = *(const LAS bf16x8*)(kb + co); a[(ks + 1) & 1][1] = *(const LAS bf16x8*)(kb + 4096 + co); }
                        if (ks == 0) { s0 = MFMA32(a[0][0], qf[0], negm); s1 = MFMA32(a[0][1], qf[0], negm); }
                        else { s0 = MFMA32(a[ks & 1][0], qf[ks], s0); s1 = MFMA32(a[ks & 1][1], qf[ks], s1); }
                        SCHEDB();
                    }
                }
                if ((q0 - (64 * jt + 63)) < 91) {
                    const int idx0 = (q0 + c) - (64 * jt + 16 * hh) + 64;
#pragma unroll
                    for (int r = 0; r < 16; ++r) { s0[r] += tab[min(idx0 - r, 255)]; s1[r] += tab[min(idx0 - 32 - r, 255)]; if ((r & 3) == 3) SCHEDB(); }
                }
                float mx;
                { float a0 = MX3(s0[0], s0[1], s1[0]), a1 = MX3(s0[2], s0[3], s1[1]); a0 = MX3(a0, s1[2], s1[3]);
#pragma unroll
                  for (int r = 4; r < 16; r += 4) { a0 = MX3(a0, s0[r], s0[r + 1]); a1 = MX3(a1, s0[r + 2], s0[r + 3]); a0 = MX3(a0, s1[r], s1[r + 1]); a1 = MX3(a1, s1[r + 2], s1[r + 3]); }
                  mx = fmaxf(a0, a1); }
                { auto rr = __builtin_amdgcn_permlane32_swap(__float_as_uint(mx), __float_as_uint(mx), false, false); mx = fmaxf(__uint_as_float(rr[0]), __uint_as_float(rr[1])); }
                const bool first = (jt == 0);
                if (first || __any(mx > 8.0f)) {
                    const float dl = first ? mx : fmaxf(mx, 0.f);
                    m += dl;
#pragma unroll
                    for (int r = 0; r < 16; ++r) { s0[r] -= dl; s1[r] -= dl; }
#pragma unroll
                    for (int r = 0; r < 16; ++r) negm[r] = -m;
                    if (!first) {
                        const float alpha = ex2(-dl);
                        int hl = hh; asm volatile("" : "+v"(hl));
#pragma unroll
                        for (int r = 0; r < 16; ++r) { const float a = __shfl(alpha, crow(r, hl)); L[r] *= a;
#pragma unroll
                            for (int db = 0; db < 4; ++db) O[db][r] *= a; }
                    }
                }
#pragma unroll
                for (int r = 0; r < 16; ++r) s0[r] = ex2(s0[r]);
#pragma unroll
                for (int g = 0; g < 4; ++g) {
                    const int co = ((4 * (g >> 1) + (g & 1)) ^ xv) << 4;
                    bf16x8 vf[4];
#pragma unroll
                    for (int db = 0; db < 4; ++db) vf[db] = *(const LAS bf16x8*)(vb + db * 4096 + co);
                    const bf16x8 pf = pack8((g >> 1) ? s1 : s0, 8 * (g & 1));
#pragma unroll
                    for (int db = 0; db < 4; ++db) O[db] = MFMA32(pf, vf[db], O[db]);
                    L = MFMA32(pf, ones, L);
                    if (g < 2) {
#pragma unroll
                        for (int r = 0; r < 8; ++r) s1[8 * g + r] = ex2(s1[8 * g + r]);
                    }
                    SCHEDB();
                }
            }
            asm volatile("s_waitcnt vmcnt(0)" ::: "memory");
            __syncthreads();
        }
#pragma unroll
        for (int r = 0; r < 16; ++r) { const float a = (mp == 0 ? 1.0f : lam) / L[r];
#pragma unroll
            for (int db = 0; db < 4; ++db) O[db][r] *= a; }
        if (mp == 0) {
#pragma unroll
            for (int db = 0; db < 4; ++db)
#pragma unroll
                for (int j = 0; j < 8; ++j) park[(db * 8 + j) * 64] = cvtpk(O[db][2 * j], O[db][2 * j + 1]);
        }
    }
    float gn[4];
#pragma unroll
    for (int db = 0; db < 4; ++db) gn[db] = p.diff_gain[32 * db + c] * 0.8f;
#pragma unroll
    for (int r = 0; r < 16; ++r) {
        const int qr = crow(r, hh);
        float o[4]; float ss = 0.f;
#pragma unroll
        for (int db = 0; db < 4; ++db) { const unsigned w = park[(db * 8 + (r >> 1)) * 64]; o[db] = ((r & 1) ? bf_hi(w) : bf_lo(w)) - O[db][r]; ss += o[db] * o[db]; }
#pragma unroll
        for (int off = 1; off < 32; off <<= 1) ss += __shfl_xor(ss, off);
        const float rs = 1.0f / sqrtf(ss * (1.0f / 128.0f) + EPS);
        bf16_t* op = AO + (rowbase + q0 + qr) * DM + h * 128 + c;
#pragma unroll
        for (int db = 0; db < 4; ++db) op[32 * db] = (bf16_t)(cvtpk(o[db] * rs * gn[db], 0.f) & 0xffffu);
    }
}
#undef MX3

__device__ __forceinline__ void sb_unit(const Params& p, LAS unsigned char* lds, int b, int h, int qb) {
    int tid_ = threadIdx.x; asm volatile("" : "+v"(tid_));
    const int tid = tid_, lane = tid & 63, wid = __builtin_amdgcn_readfirstlane(tid >> 6), c = lane & 31, hh = lane >> 5;
    const bf16_t* QK = (const bf16_t*)(p.ws + WS_QK); const bf16_t* VT = (const bf16_t*)(p.ws + WS_VT); bf16_t* AO = (bf16_t*)(p.ws + WS_AO);
    const size_t rowbase = (size_t)b * SEQ;
    const int q0 = qb * 256 + wid * 32, mylast = q0 >> 6, T0 = 4 * qb + 3;
    const int xk = (c & 15) ^ hh, xv = ((c >> 1) & 7) ^ (2 * hh);
    LAS unsigned* flag = (LAS unsigned*)(lds + A_FLAG);
    const bf16_t* Kg0 = (const bf16_t*)(p.ws + WS_KS) + ((size_t)h * MT + rowbase) * 128;
    const bf16_t* Vg0 = VT + ((size_t)(8 + h) * 512 + (size_t)b * 64) * 8192;
    tile_dma<128>(Kg0 + (size_t)T0 * 8192, Vg0 + (size_t)T0 * 8192, lds + A_KOFF, lds + A_VOFF, wid, lane);
    const bf16_t* qp = QK + (rowbase + q0 + c) * 4096 + 2048 + h * 128 + hh * 8;
    bf16x8 qf[8];
#pragma unroll
    for (int ks = 0; ks < 8; ++ks) qf[ks] = *(const bf16x8*)(qp + 16 * ks);
    f32x16 O[4];
#pragma unroll
    for (int db = 0; db < 4; ++db) O[db] = (f32x16){};
    float carry = 0.f; bool done = false;
    asm volatile("s_waitcnt vmcnt(0)" ::: "memory");
    __syncthreads();
    for (int jt = T0; jt >= 0; --jt) {
        const int cur = (T0 - jt) & 1;
        if (jt > 0) tile_dma<128>(Kg0 + (size_t)(jt - 1) * 8192, Vg0 + (size_t)(jt - 1) * 8192, lds + A_KOFF + (cur ^ 1) * A_KBUF, lds + A_VOFF + (cur ^ 1) * A_VBUF, wid, lane);
        if (jt <= mylast && !done) {
            const LAS unsigned char* kb = lds + A_KOFF + cur * A_KBUF + c * 256;
            const LAS unsigned char* vb = lds + A_VOFF + cur * A_VBUF + c * 128;
            f32x16 s0 = (f32x16){}, s1 = (f32x16){};
            qk_tile<8, 256>(s0, s1, kb, xk, qf);
            const bool diag = (jt == mylast);
            const int lim = (q0 + c) - (64 * jt + 16 * hh);
            float run = 0.f;
#pragma unroll
            for (int r = 15; r >= 0; --r) {
                const float z = s1[r]; const float sp = fmaxf(z, 0.f) + lg2(1.0f + ex2(-fabsf(z)));
                float lk = -sp, lb = z - sp;
                if (diag && !(r + 32 < lim)) { lk = 0.f; lb = -1e30f; }
                s1[r] = lb + run; run += lk;
            }
            const float T1 = run; run = 0.f;
#pragma unroll
            for (int r = 15; r >= 0; --r) {
                const float z = s0[r]; const float sp = fmaxf(z, 0.f) + lg2(1.0f + ex2(-fabsf(z)));
                float lk = -sp, lb = z - sp;
                if (diag && !(r < lim)) { lk = 0.f; lb = -1e30f; }
                s0[r] = lb + run; run += lk;
            }
            const float T0s = run;
            const float T1p = __shfl_xor(T1, 32), T0p = __shfl_xor(T0s, 32);
            const float off1 = carry + (hh ? 0.f : T1p);
            const float off0 = carry + T1 + T1p + (hh ? 0.f : T0p);
#pragma unroll
            for (int r = 0; r < 16; ++r) { s1[r] = ex2(s1[r] + off1); s0[r] = ex2(s0[r] + off0); }
            carry += (T1 + T1p) + (T0s + T0p);
            pv_acc(O, s0, s1, vb, xv);
            done = __all(carry < -60.0f);
        }
        if (lane == 0) flag[cur * 8 + wid] = done ? 1u : 0u;
        asm volatile("s_waitcnt vmcnt(0)" ::: "memory");
        __syncthreads();
        const u32x4 f0 = *(const LAS u32x4*)(flag + cur * 8), f1 = *(const LAS u32x4*)(flag + cur * 8 + 4);
        if ((f0.x & f0.y & f0.z & f0.w & f1.x & f1.y & f1.z & f1.w) != 0u) break;
    }
    float gn[4];
#pragma unroll
    for (int db = 0; db < 4; ++db) gn[db] = p.sb_gain[32 * db + c];
#pragma unroll
    for (int r = 0; r < 16; ++r) {
        const int qr = crow(r, hh);
        float ss = 0.f;
#pragma unroll
        for (int db = 0; db < 4; ++db) ss += O[db][r] * O[db][r];
#pragma unroll
        for (int off = 1; off < 32; off <<= 1) ss += __shfl_xor(ss, off);
        const float rs = 1.0f / sqrtf(ss * (1.0f / 128.0f) + EPS);
        bf16_t* op = AO + (rowbase + q0 + qr) * DM + 1024 + h * 128 + c;
#pragma unroll
        for (int db = 0; db < 4; ++db) op[32 * db] = (bf16_t)(cvtpk(O[db][r] * rs * gn[db], 0.f) & 0xffffu);
    }
    asm volatile("s_waitcnt vmcnt(0)" ::: "memory");
    __syncthreads();
}

__device__ __forceinline__ void attention_phase(const Params& p, LAS unsigned char* lds, int G, int blk) {
    float s1 = 0.f, s2 = 0.f;
    for (int i = 0; i < 64; ++i) { s1 += p.lq1[i] * p.lk1[i]; s2 += p.lq2[i] * p.lk2[i]; }
    const float lam = expf(s1) - expf(s2) + 0.2f;
    const int v = (G % 8 == 0) ? (blk % 8) * (G / 8) + blk / 8 : blk;
    for (int rep = 0; rep < PROBE_DIFF_REPS; ++rep)
    for (int u = v; u < 1024; u += G) {
        const int bh = (u & 255) >> 2, s = u & 3, i = u >> 8;
        const int qb = (i == 0) ? s : (i == 1) ? 7 - s : (i == 2) ? 8 + s : 15 - s;
#ifndef NO_DIFF
        diff_unit(p, lds, bh >> 3, bh & 7, qb, lam);
#endif
    }
    for (int rep = 0; rep < PROBE_SB_REPS; ++rep)
    for (int u = v; u < 1024; u += G) {
        const int bh = (u & 255) >> 2, s = u & 3, i = u >> 8;
        const int qb = (i == 0) ? s : (i == 1) ? 7 - s : (i == 2) ? 8 + s : 15 - s;
#ifndef NO_SB
        sb_unit(p, lds, bh >> 3, bh & 7, qb);
#endif
    }
}

constexpr int LDS_BYTES = 143360;

__global__ void __launch_bounds__(512) fwd_megakernel(Params p) {
    extern __shared__ __attribute__((aligned(16))) unsigned char lds_raw[];
    LAS unsigned char* lds = (LAS unsigned char*)lds_raw;
    cg::grid_group grid = cg::this_grid();
    const int G = gridDim.x, blk = blockIdx.x;
    unsigned char* ws = p.ws;

#ifdef ONLY_GEMM
#define GEMM(gi) do { if (gi == ONLY_GEMM) pg8::gemm_phase<gi>(lds, ws, G, blk); } while (0)
#else
#define GEMM(gi) pg8::gemm_phase<gi>(lds, ws, G, blk)
#endif
    volatile LAS unsigned* xst = (volatile LAS unsigned*)(lds + 131072);
    unsigned* barw = (unsigned*)ws;
    if (threadIdx.x < 2) xst[threadIdx.x] = 0u;
    if (blk == 0) for (int i = threadIdx.x; i < XCD_BAR_WORDS; i += 512) barw[i] = 0u;
    prologue(p, lds, G, blk);
#ifdef PROBE_PRO2
    __syncthreads(); prologue(p, lds, G, blk);
#endif
    grid.sync();
    XcdBarrier xbar = xcd_barrier_post(barw, xst);
    GEMM(0); GEMM(1); GEMM(2);
#ifdef PROBE_G012
    GEMM(0); GEMM(1); GEMM(2);
#endif
    GSYNC();
    attention_phase(p, lds, G, blk); GSYNC();
    GEMM(3); GEMM(4); GEMM(5); GSYNC();
    row_pass<true, false, true>((const bf16_t*)(ws + WS_MIX), p.x, ws + WS_XR, p.g_mix_post, p.g_mem_pre, (bf16_t*)(ws + WS_H), G, blk);
#ifdef PROBE_R12
    row_pass<true, false, true>((const bf16_t*)(ws + WS_MIX), p.x, ws + WS_XR, p.g_mix_post, p.g_mem_pre, (bf16_t*)(ws + WS_H), G, blk);
#endif
    GSYNC();
    GEMM(6); GSYNC();
    GEMM(7); GSYNC();
    row_pass<true, true, true>((const bf16_t*)(ws + WS_MEMO), ws + WS_XR, ws + WS_XR, p.g_mem_post, p.g_ffn_pre, (bf16_t*)(ws + WS_H), G, blk); GSYNC();
    GEMM(8);
#ifdef PROBE_G8
    GEMM(8);
#endif
    GSYNC();
    GEMM(9);
#ifdef PROBE_G9
    GEMM(9);
#endif
    GSYNC();
    row_pass<false, true, false>((const bf16_t*)(ws + WS_FO), ws + WS_XR, p.out, p.g_ffn_post, nullptr, nullptr, G, blk);
#undef GEMM
}

extern "C" void kernel_launch(void* const* d_in, const int* in_sizes, int n_in, void* d_out, int out_size, void* d_ws, size_t ws_size, hipStream_t stream) {
    static int grid_blocks = 0;
    if (grid_blocks == 0) {
        if (n_in != 23 || ws_size < WS_END) { fprintf(stderr, "kernel_launch: unexpected n_in %d / ws %zu\n", n_in, ws_size); grid_blocks = -1; return; }
        int dev = 0, cus = 0, per_cu = 0;
        hipGetDevice(&dev);
        hipDeviceGetAttribute(&cus, hipDeviceAttributeMultiprocessorCount, dev);
        if (hipFuncSetAttribute((const void*)fwd_megakernel, hipFuncAttributeMaxDynamicSharedMemorySize, LDS_BYTES) != hipSuccess) { fprintf(stderr, "kernel_launch: hipFuncSetAttribute failed\n"); }
        if (hipOccupancyMaxActiveBlocksPerMultiprocessor(&per_cu, (const void*)fwd_megakernel, 512, LDS_BYTES) != hipSuccess || per_cu < 1) { fprintf(stderr, "kernel_launch: occupancy query gave %d\n", per_cu); per_cu = 1; }
        (void)hipGetLastError();
        grid_blocks = cus * 1;
        if (grid_blocks > 256) grid_blocks = 256;
    }
    if (grid_blocks < 0) return;
    Params p{};
    const float* const* in = (const float* const*)d_in;
    p.x = in[0]; p.mem = in[1]; p.w_in = in[2]; p.w_out = in[3]; p.rel_bias = in[4];
    p.lq1 = in[5]; p.lk1 = in[6]; p.lq2 = in[7]; p.lk2 = in[8];
    p.diff_gain = in[9]; p.sb_gain = in[10]; p.g_mix_pre = in[11]; p.g_mix_post = in[12];
    p.w_mq = in[13]; p.w_mkv = in[14]; p.w_mo = in[15]; p.g_mem_kv = in[16]; p.g_mem_pre = in[17]; p.g_mem_post = in[18];
    p.w_gu = in[19]; p.w_down = in[20]; p.g_ffn_pre = in[21]; p.g_ffn_post = in[22];
    p.out = (float*)d_out; p.ws = (unsigned char*)d_ws;
    void* args[] = {&p};
    hipError_t e = hipLaunchCooperativeKernel((const void*)fwd_megakernel, dim3(grid_blocks), dim3(512), args, LDS_BYTES, stream);
    if (e != hipSuccess) fprintf(stderr, "cooperative launch failed: %s (grid %d)\n", hipGetErrorString(e), grid_blocks);
}
```

```cpp
#define GSYNC() xcd_barrier(xbar)
#include <hip/hip_runtime.h>
#include <hip/hip_cooperative_groups.h>
#include <cstdint>
#include <cstdio>
namespace cg = cooperative_groups;

#define LAS __attribute__((address_space(3)))
typedef unsigned short bf16_t;
typedef short bf16x8 __attribute__((ext_vector_type(8)));
typedef float f32x4 __attribute__((ext_vector_type(4)));
typedef float f32x16 __attribute__((ext_vector_type(16)));
typedef unsigned u32x4 __attribute__((ext_vector_type(4)));
typedef unsigned u32x2 __attribute__((ext_vector_type(2)));
typedef float f32x2_t __attribute__((ext_vector_type(2)));
typedef __bf16 bf16x2_t __attribute__((ext_vector_type(2)));

constexpr int NB = 8, SEQ = 4096, DM = 2048, MT = NB * SEQ, DFF = 5632;
constexpr float LOG2E = 1.4426950408889634f;
constexpr float EPS = 1e-6f;
constexpr size_t MiB = 1u << 20;
constexpr size_t WS_WQK = 2 * MiB, WS_WV = 18 * MiB, WS_WOUT = 26 * MiB, WS_WMQ = 34 * MiB, WS_WMKV = 42 * MiB, WS_WMO = 58 * MiB,
                 WS_WGU = 66 * MiB, WS_WDN = 110 * MiB, WS_MEMN = 132 * MiB, WS_KVM = 140 * MiB, WS_WKT = 156 * MiB, WS_VWT = 188 * MiB,
                 WS_H = 224 * MiB, WS_QK = 352 * MiB, WS_VT = 608 * MiB, WS_AO = 736 * MiB, WS_MIX = 352 * MiB, WS_S = 480 * MiB,
                 WS_P = 608 * MiB, WS_MEMO = 672 * MiB, WS_F = 352 * MiB, WS_FO = 704 * MiB, WS_KD = 864 * MiB, WS_KS = 928 * MiB, WS_XR = 864 * MiB  , WS_PARK = 992 * MiB, WS_END = 1008 * MiB;

struct Params {
    const float* x; const float* mem; const float* w_in; const float* w_out; const float* rel_bias;
    const float* lq1; const float* lk1; const float* lq2; const float* lk2;
    const float* diff_gain; const float* sb_gain; const float* g_mix_pre; const float* g_mix_post;
    const float* w_mq; const float* w_mkv; const float* w_mo; const float* g_mem_kv; const float* g_mem_pre; const float* g_mem_post;
    const float* w_gu; const float* w_down; const float* g_ffn_pre; const float* g_ffn_post;
    float* out; unsigned char* ws;
};

__device__ __forceinline__ unsigned cvtpk(float lo, float hi) { f32x2_t v = {lo, hi}; bf16x2_t b = __builtin_convertvector(v, bf16x2_t); return __builtin_bit_cast(unsigned, b); }
__device__ __forceinline__ float bf_lo(unsigned u) { return __uint_as_float(u << 16); }
__device__ __forceinline__ float bf_hi(unsigned u) { return __uint_as_float(u & 0xffff0000u); }
__device__ __forceinline__ float wave_sum(float v) {
#pragma unroll
    for (int o = 1; o < 64; o <<= 1) v += __shfl_xor(v, o);
    return v;
}
__device__ __forceinline__ float wave_max(float v) {
#pragma unroll
    for (int o = 1; o < 64; o <<= 1) v = fmaxf(v, __shfl_xor(v, o));
    return v;
}
__device__ __forceinline__ float ex2(float v) { return __builtin_amdgcn_exp2f(v); }
__device__ __forceinline__ float lg2(float v) { return __builtin_amdgcn_logf(v); }

namespace pg8 {
constexpr int BM = 256, BK = 64, HALF = 128, HTB = HALF * BK * 2, STAGE_BYTES = 8 * HTB;
__device__ __forceinline__ int lds_byte(int r, int c) { const int st = (r >> 4) * 2 + (c >> 5), rr = r & 15, cc = c & 31, ob = rr * 64 + cc * 2; return st * 1024 + (ob ^ (((ob >> 9) & 1) << 5)); }
__device__ __forceinline__ void stage_rc(int b, int& R, int& C) { const int st = b / 1024, sb = b % 1024, swz = sb ^ (((sb >> 9) & 1) << 5); R = (st >> 1) * 16 + swz / 64; C = (st & 1) * 32 + (swz % 64) / 2; }
__device__ __forceinline__ int perm32(int rho) { const int n = rho >> 4, i = rho & 15; return 8 * (i >> 2) + 4 * n + (i & 3); }

struct GUnit { const char* A; const char* B; char* C; int SA, SR, SB, SX; float scale; };

struct GemmDesc {
    size_t A, B, C;
    int K, lda, ldb, ldc;
    int nM, nN;
    int kind, mode;
    int scale_kind;
    float scale;
    size_t a_tile, b_tile, b_batch, c_rt, c_ct;
    size_t a_b, a_h, a_t, b_b, b_h, b_t, c_b, c_h, c_t;
};

constexpr GemmDesc make_desc(int gi) {
    GemmDesc d{};
    d.scale = 1.0f; d.kind = 0; d.mode = 0; d.scale_kind = 0;
    switch (gi) {
    case 0:
        d.A = WS_H; d.B = WS_WQK; d.C = WS_QK;
        d.K = 2048; d.lda = 2048; d.ldb = 2048; d.ldc = 4096; d.nM = 128; d.nN = 16; d.scale_kind = 1;
        d.a_tile = (size_t)256 * 2048 * 2; d.b_tile = (size_t)256 * 2048 * 2; d.c_rt = (size_t)256 * 4096 * 2; d.c_ct = 512; break;
    case 1:
        d.A = WS_WV; d.B = WS_H; d.C = WS_VT;
        d.K = 2048; d.lda = 2048; d.ldb = 2048; d.ldc = MT; d.nM = 8; d.nN = 128; d.scale_kind = 2;
        d.a_tile = (size_t)256 * 2048 * 2; d.b_tile = (size_t)256 * 2048 * 2; d.c_rt = (size_t)256 * MT * 2; d.c_ct = 512; break;
    case 2:
        d.A = WS_MEMN; d.B = WS_WMKV; d.C = WS_KVM;
        d.K = 2048; d.lda = 2048; d.ldb = 2048; d.ldc = 4096; d.nM = 8; d.nN = 16;
        d.a_tile = (size_t)256 * 2048 * 2; d.b_tile = (size_t)256 * 2048 * 2; d.c_rt = (size_t)256 * 4096 * 2; d.c_ct = 512; break;
    case 3:
        d.A = WS_AO; d.B = WS_WOUT; d.C = WS_MIX;
        d.K = 2048; d.lda = 2048; d.ldb = 2048; d.ldc = 2048; d.nM = 128; d.nN = 8;
        d.a_tile = (size_t)256 * 2048 * 2; d.b_tile = (size_t)256 * 2048 * 2; d.c_rt = (size_t)256 * 2048 * 2; d.c_ct = 512; break;
    case 4:
        d.kind = 1; d.A = WS_KVM; d.B = WS_WMQ; d.C = WS_WKT;
        d.K = 512; d.lda = 4096; d.ldb = 2048; d.ldc = 2048; d.scale = 0.04419417382415922f * LOG2E;
        d.a_b = (size_t)256 * 4096 * 2; d.a_h = 1024; d.a_t = 0;
        d.b_b = 0; d.b_h = 1024; d.b_t = (size_t)256 * 2048 * 2;
        d.c_b = (size_t)1024 * 2048 * 2; d.c_h = (size_t)256 * 2048 * 2; d.c_t = 512; break;
    case 5:
        d.kind = 1; d.A = WS_WMO; d.B = WS_KVM + 4096; d.C = WS_VWT;
        d.K = 512; d.lda = 2048; d.ldb = 4096; d.ldc = 1024;
        d.a_b = 0; d.a_h = 1024; d.a_t = (size_t)256 * 2048 * 2;
        d.b_b = (size_t)256 * 4096 * 2; d.b_h = 1024; d.b_t = 0;
        d.c_b = (size_t)2048 * 1024 * 2; d.c_h = 512; d.c_t = (size_t)256 * 1024 * 2; break;
    case 6:
        d.A = WS_H; d.B = WS_WKT; d.C = WS_P; d.mode = 3;
        d.K = 2048; d.lda = 2048; d.ldb = 2048; d.ldc = 1024; d.nM = 128; d.nN = 4;
        d.a_tile = (size_t)256 * 2048 * 2; d.b_tile = (size_t)256 * 2048 * 2; d.b_batch = (size_t)1024 * 2048 * 2; d.c_rt = (size_t)256 * 1024 * 2; d.c_ct = 512; break;
    case 7:
        d.A = WS_P; d.B = WS_VWT; d.C = WS_MEMO;
        d.K = 1024; d.lda = 1024; d.ldb = 1024; d.ldc = 2048; d.nM = 128; d.nN = 8;
        d.a_tile = (size_t)256 * 1024 * 2; d.b_tile = (size_t)256 * 1024 * 2; d.b_batch = (size_t)2048 * 1024 * 2; d.c_rt = (size_t)256 * 2048 * 2; d.c_ct = 512; break;
    case 8:
        d.A = WS_H; d.B = WS_WGU; d.C = WS_F; d.mode = 2;
        d.K = 2048; d.lda = 2048; d.ldb = 2048; d.ldc = DFF; d.nM = 128; d.nN = 44;
        d.a_tile = (size_t)256 * 2048 * 2; d.b_tile = (size_t)256 * 2048 * 2; d.c_rt = (size_t)256 * DFF * 2; d.c_ct = 256; break;
    default:
        d.A = WS_F; d.B = WS_WDN; d.C = WS_FO;
        d.K = DFF; d.lda = DFF; d.ldb = DFF; d.ldc = 2048; d.nM = 128; d.nN = 8;
        d.a_tile = (size_t)256 * DFF * 2; d.b_tile = (size_t)256 * DFF * 2; d.c_rt = (size_t)256 * 2048 * 2; d.c_ct = 512; break;
    }
    return d;
}

template <int GI>
__device__ __forceinline__ bool sched_next(unsigned char* ws, int i, int G, int c, GUnit& u) {
    constexpr GemmDesc d = make_desc(GI);
    const int L = i * G + c;
    u.SA = 128 * d.ldc; u.SR = d.ldc; u.SB = 128; u.SX = 64; u.scale = d.scale;
    if (d.kind == 0) {
        constexpr int nwg = d.nM * d.nN;
        if (L >= nwg) return false;
        int wgid = L;
        { constexpr int q = nwg / 8, r = nwg % 8; const int xcd = wgid % 8, off = wgid / 8; wgid = (xcd < r ? xcd * (q + 1) : r * (q + 1) + (xcd - r) * q) + off; }
        constexpr int nig = 8 * d.nN; const int gid = wgid / nig, fm = gid * 8, gsz = (d.nM - fm) < 8 ? (d.nM - fm) : 8;
        const int pm = fm + ((wgid % nig) % gsz), pn = (wgid % nig) / gsz;
        u.A = (const char*)ws + d.A + (size_t)pm * d.a_tile;
        u.B = (const char*)ws + d.B + (size_t)(pm >> 4) * d.b_batch + (size_t)pn * d.b_tile;
        u.C = (char*)ws + d.C + (size_t)pm * d.c_rt + (size_t)pn * d.c_ct;
        if (d.scale_kind == 1) {
            u.scale = (pn < 4) ? 0.125f * LOG2E : ((pn >= 8 && pn < 12) ? 0.08838834764831845f * LOG2E : 1.0f);
            if (pn >= 4 && pn < 8) {
                u.C = (char*)ws + WS_KD + ((size_t)(4 * (pn - 4)) * MT + (size_t)pm * 256) * 64 * 2;
                u.SA = 128 * 64; u.SR = 64; u.SB = 2 * MT * 64; u.SX = MT * 64;
            } else if (pn >= 12) {
                u.C = (char*)ws + WS_KS + ((size_t)(2 * (pn - 12)) * MT + (size_t)pm * 256) * 128 * 2;
                u.SA = 128 * 128; u.SR = 128; u.SB = MT * 128; u.SX = 64;
            }
        } else if (d.scale_kind == 2) {
            u.C = (char*)ws + WS_VT + ((size_t)(2 * pm) * 512 + (size_t)(4 * pn)) * 8192 * 2;
            u.SA = 512 * 8192; u.SR = 64; u.SB = 2 * 8192; u.SX = 8192;
        }
        return true;
    } else {
        if (L >= 256) return false;
        const int z = L >> 3, t = L & 7, b = z >> 2, h = z & 3;
        u.A = (const char*)ws + d.A + (size_t)b * d.a_b + (size_t)h * d.a_h + (size_t)t * d.a_t;
        u.B = (const char*)ws + d.B + (size_t)b * d.b_b + (size_t)h * d.b_h + (size_t)t * d.b_t;
        u.C = (char*)ws + d.C + (size_t)b * d.c_b + (size_t)h * d.c_h + (size_t)t * d.c_t;
        return true;
    }
}

template <int mode>
__device__ __forceinline__ void epilogue(f32x4 (&acc)[2][2][4][2], const GUnit& u, int wr, int wc, int fr, int fq, LAS unsigned char* lds) {
    if (mode == 0) {
        bf16_t* base = (bf16_t*)u.C; const float sc = u.scale;
#pragma unroll
        for (int ai = 0; ai < 2; ++ai)
#pragma unroll
            for (int m = 0; m < 4; ++m) {
                bf16_t* rowp = base + (size_t)ai * u.SA + (size_t)(wr * 64 + m * 16 + fr) * u.SR + (wc >> 1) * u.SX + (wc & 1) * 32 + 8 * fq;
#pragma unroll
                for (int bj = 0; bj < 2; ++bj) {
                    const f32x4 v0 = acc[ai][bj][m][0] * sc, v1 = acc[ai][bj][m][1] * sc;
                    u32x4 w; w.x = cvtpk(v0[0], v0[1]); w.y = cvtpk(v0[2], v0[3]); w.z = cvtpk(v1[0], v1[1]); w.w = cvtpk(v1[2], v1[3]);
                    *(u32x4*)(rowp + (size_t)bj * u.SB) = w;
                }
            }
    } else if (mode == 1) {
        float* base = (float*)u.C; const float sc = u.scale;
#pragma unroll
        for (int ai = 0; ai < 2; ++ai)
#pragma unroll
            for (int m = 0; m < 4; ++m) {
                float* rowp = base + (size_t)ai * u.SA + (size_t)(wr * 64 + m * 16 + fr) * u.SR + (wc >> 1) * u.SX + (wc & 1) * 32 + 8 * fq;
#pragma unroll
                for (int bj = 0; bj < 2; ++bj) {
                    *(f32x4*)(rowp + (size_t)bj * u.SB) = acc[ai][bj][m][0] * sc;
                    *(f32x4*)(rowp + (size_t)bj * u.SB + 4) = acc[ai][bj][m][1] * sc;
                }
            }
    } else if (mode == 3) {
        LAS f32x2_t* X = (LAS f32x2_t*)(lds + 131200);
#pragma unroll
        for (int ai = 0; ai < 2; ++ai)
#pragma unroll
            for (int m = 0; m < 4; ++m) {
                float mx = -1e30f;
#pragma unroll
                for (int bj = 0; bj < 2; ++bj)
#pragma unroll
                    for (int n = 0; n < 2; ++n) { const f32x4 v = acc[ai][bj][m][n]; mx = fmaxf(mx, fmaxf(fmaxf(v[0], v[1]), fmaxf(v[2], v[3]))); }
                mx = fmaxf(mx, __shfl_xor(mx, 16)); mx = fmaxf(mx, __shfl_xor(mx, 32));
                float sum = 0.f;
#pragma unroll
                for (int bj = 0; bj < 2; ++bj)
#pragma unroll
                    for (int n = 0; n < 2; ++n) { f32x4 v = acc[ai][bj][m][n]; v[0] = ex2(v[0] - mx); v[1] = ex2(v[1] - mx); v[2] = ex2(v[2] - mx); v[3] = ex2(v[3] - mx);
                        acc[ai][bj][m][n] = v; sum += (v[0] + v[1]) + (v[2] + v[3]); }
                sum += __shfl_xor(sum, 16); sum += __shfl_xor(sum, 32);
                if (fq == 0) X[(ai * HALF + wr * 64 + m * 16 + fr) * 4 + wc] = (f32x2_t){mx, sum};
            }
        asm volatile("s_waitcnt lgkmcnt(0)" ::: "memory"); __builtin_amdgcn_s_barrier(); asm volatile("" ::: "memory");
        bf16_t* base = (bf16_t*)u.C;
#pragma unroll
        for (int ai = 0; ai < 2; ++ai)
#pragma unroll
            for (int m = 0; m < 4; ++m) {
                const int row = ai * HALF + wr * 64 + m * 16 + fr;
                const f32x2_t a0 = X[row * 4 + 0], a1 = X[row * 4 + 1], a2 = X[row * 4 + 2], a3 = X[row * 4 + 3];
                const float M = fmaxf(fmaxf(a0.x, a1.x), fmaxf(a2.x, a3.x));
                const float tot = (a0.y * ex2(a0.x - M) + a1.y * ex2(a1.x - M)) + (a2.y * ex2(a2.x - M) + a3.y * ex2(a3.x - M));
                const float own = (wc == 0) ? a0.x : (wc == 1) ? a1.x : (wc == 2) ? a2.x : a3.x;
                const float f = ex2(own - M) / tot;
                bf16_t* rowp = base + (size_t)ai * u.SA + (size_t)(wr * 64 + m * 16 + fr) * u.SR + (wc >> 1) * u.SX + (wc & 1) * 32 + 8 * fq;
#pragma unroll
                for (int bj = 0; bj < 2; ++bj) {
                    const f32x4 v0 = acc[ai][bj][m][0] * f, v1 = acc[ai][bj][m][1] * f;
                    u32x4 w; w.x = cvtpk(v0[0], v0[1]); w.y = cvtpk(v0[2], v0[3]); w.z = cvtpk(v1[0], v1[1]); w.w = cvtpk(v1[2], v1[3]);
                    *(u32x4*)(rowp + (size_t)bj * u.SB) = w;
                }
            }
    } else {
        bf16_t* base = (bf16_t*)u.C;
#pragma unroll
        for (int ai = 0; ai < 2; ++ai)
#pragma unroll
            for (int m = 0; m < 4; ++m) {
                bf16_t* rowp = base + (size_t)ai * u.SA + (size_t)(wr * 64 + m * 16 + fr) * u.SR + (wc >> 1) * u.SX + (wc & 1) * 32 + 8 * fq;
                float y[8];
#pragma unroll
                for (int n = 0; n < 2; ++n)
#pragma unroll
                    for (int j = 0; j < 4; ++j) {
                        const float g = acc[ai][0][m][n][j], up = acc[ai][1][m][n][j];
                        y[n * 4 + j] = g * __builtin_amdgcn_rcpf(1.0f + ex2(-g * LOG2E)) * up;
                    }
                u32x4 w; w.x = cvtpk(y[0], y[1]); w.y = cvtpk(y[2], y[3]); w.z = cvtpk(y[4], y[5]); w.w = cvtpk(y[6], y[7]);
                *(u32x4*)rowp = w;
            }
    }
}

template <int GI>
__device__ __forceinline__ void gemm_phase(LAS unsigned char* lds, unsigned char* ws, int G, int cblk) {
    constexpr GemmDesc g = make_desc(GI);
    int tid_ = threadIdx.x; asm volatile("" : "+v"(tid_));
    const int tid = tid_, wid = __builtin_amdgcn_readfirstlane(tid >> 6), lane = tid & 63, wr = wid >> 2, wc = wid & 3, fr = lane & 15, fq = lane >> 4;
    constexpr int K = g.K, nt = K / BK, lda = g.lda, ldb = g.ldb;
    unsigned voffA[2], voffB[2];
#pragma unroll
    for (int i = 0; i < 2; ++i) { int R, C; stage_rc(tid * 16 + i * 8192, R, C); const int Rb = (R & ~31) + perm32(R & 31);
        voffA[i] = (unsigned)(R * lda + C) * 2u; voffB[i] = (unsigned)(Rb * ldb + C) * 2u; }
    const size_t kstep = (size_t)(BK * 2);
    const size_t hstepA = (size_t)HALF * lda * 2, hstepB = (size_t)HALF * ldb * 2;
    const unsigned ldsw = (unsigned)wid * 1024u;
    const int aoff = lds_byte(wr * 64 + fr, fq * 8), boff = lds_byte(wc * 32 + fr, fq * 8);
#define PG8_SA(b, h) (((b) * 2 + (h)) * HTB)
#define PG8_SB(b, h) ((4 + (b) * 2 + (h)) * HTB)
#define PG8_STAGE(bufoff, gbase, voff) do { _Pragma("unroll") for (int _i = 0; _i < 2; ++_i) \
        __builtin_amdgcn_global_load_lds((const unsigned*)((const char*)(gbase) + (voff)[_i]), (LAS unsigned*)(lds + (bufoff) + ldsw + _i * 8192), 16, 0, 0); } while (0)
#define PG8_LDA(dst, b, h) do { _Pragma("unroll") for (int m = 0; m < 4; ++m) _Pragma("unroll") for (int k = 0; k < 2; ++k) dst[m][k] = *(const LAS bf16x8*)(lds + PG8_SA(b, h) + aoff + m * 2048 + k * 1024); } while (0)
#define PG8_LDB(dst, b, h) do { _Pragma("unroll") for (int n = 0; n < 2; ++n) _Pragma("unroll") for (int k = 0; k < 2; ++k) dst[n][k] = *(const LAS bf16x8*)(lds + PG8_SB(b, h) + boff + n * 2048 + k * 1024); } while (0)
#define PG8_MMA(ai, bj, At, Bt) do { __builtin_amdgcn_s_setprio(1); _Pragma("unroll") for (int m = 0; m < 4; ++m) _Pragma("unroll") for (int n = 0; n < 2; ++n) _Pragma("unroll") for (int k = 0; k < 2; ++k) \
        acc[ai][bj][m][n] = __builtin_amdgcn_mfma_f32_16x16x32_bf16(Bt[n][k], At[m][k], acc[ai][bj][m][n], 0, 0, 0); __builtin_amdgcn_s_setprio(0); } while (0)
#define PG8_WAIT_V(n) asm volatile("s_waitcnt vmcnt(" #n ")" ::: "memory")
#define PG8_WAIT_L(n) asm volatile("s_waitcnt lgkmcnt(" #n ")" ::: "memory")
#define PG8_BAR __builtin_amdgcn_s_barrier()
#define PG8_SCHED __builtin_amdgcn_sched_barrier(0)
    GUnit cur, nxt; int ui = 0;
    if (!sched_next<GI>(ws, 0, G, cblk, cur)) return;
    f32x4 acc[2][2][4][2];
#pragma unroll
    for (int a = 0; a < 2; ++a)
#pragma unroll
        for (int b = 0; b < 2; ++b)
#pragma unroll
            for (int m = 0; m < 4; ++m)
#pragma unroll
                for (int n = 0; n < 2; ++n) acc[a][b][m][n] = (f32x4){0.f, 0.f, 0.f, 0.f};
    bf16x8 At[4][2], B0[2][2], B1[2][2];
    const char* cA = cur.A; const char* cB = cur.B;
    PG8_STAGE(PG8_SB(0, 0), cB, voffB); PG8_STAGE(PG8_SB(0, 1), cB + hstepB, voffB); PG8_STAGE(PG8_SA(0, 0), cA, voffA); PG8_STAGE(PG8_SA(0, 1), cA + hstepA, voffA);
    if (wr == 1) PG8_BAR;
    PG8_WAIT_V(2); PG8_BAR;
    PG8_STAGE(PG8_SB(1, 0), cB + kstep, voffB); PG8_STAGE(PG8_SA(1, 0), cA + kstep, voffA); PG8_STAGE(PG8_SB(1, 1), cB + hstepB + kstep, voffB);
    PG8_WAIT_V(6); PG8_BAR;
    for (;;) {
        const bool has_next = sched_next<GI>(ws, ui + 1, G, cblk, nxt);
        const char* nA = has_next ? nxt.A : cA; const char* nB = has_next ? nxt.B : cB;
        for (int t = 0; t < nt; t += 2) {
            const bool last = (t == nt - 2);
            const char* a1 = cA + (size_t)(t + 1) * kstep;
            const char* a2 = last ? nA : cA + (size_t)(t + 2) * kstep; const char* b2 = last ? nB : cB + (size_t)(t + 2) * kstep;
            const char* a3 = a2 + kstep; const char* b3 = b2 + kstep;
            PG8_LDB(B0, 0, 0); PG8_LDB(B1, 0, 1); PG8_SCHED; PG8_LDA(At, 0, 0); PG8_STAGE(PG8_SA(1, 1), a1 + hstepA, voffA);
            PG8_WAIT_V(8); PG8_WAIT_L(0); PG8_BAR; PG8_MMA(0, 0, At, B0); PG8_MMA(0, 1, At, B1); PG8_BAR; PG8_SCHED;
            PG8_LDA(At, 0, 1); PG8_STAGE(PG8_SB(0, 0), b2, voffB); PG8_STAGE(PG8_SB(0, 1), b2 + hstepB, voffB); PG8_STAGE(PG8_SA(0, 0), a2, voffA);
            PG8_WAIT_V(8); PG8_WAIT_L(0); PG8_BAR; PG8_MMA(1, 0, At, B0); PG8_MMA(1, 1, At, B1); PG8_BAR; PG8_SCHED;
            PG8_LDB(B0, 1, 0); PG8_LDB(B1, 1, 1); PG8_SCHED; PG8_LDA(At, 1, 0); PG8_STAGE(PG8_SA(0, 1), a2 + hstepA, voffA);
            PG8_WAIT_V(8); PG8_WAIT_L(0); PG8_BAR; PG8_MMA(0, 0, At, B0); PG8_MMA(0, 1, At, B1); PG8_BAR; PG8_SCHED;
            PG8_LDA(At, 1, 1); PG8_STAGE(PG8_SB(1, 0), b3, voffB); PG8_STAGE(PG8_SB(1, 1), b3 + hstepB, voffB); PG8_STAGE(PG8_SA(1, 0), a3, voffA);
            PG8_WAIT_V(8); PG8_WAIT_L(0); PG8_BAR; PG8_MMA(1, 0, At, B0); PG8_MMA(1, 1, At, B1); PG8_BAR; PG8_SCHED;
        }
        if (wr == 0) PG8_BAR;
        epilogue<g.mode>(acc, cur, wr, wc, fr, fq, lds);
        if (!has_next) break;
#pragma unroll
        for (int a = 0; a < 2; ++a)
#pragma unroll
            for (int b = 0; b < 2; ++b)
#pragma unroll
                for (int m = 0; m < 4; ++m)
#pragma unroll
                    for (int n = 0; n < 2; ++n) acc[a][b][m][n] = (f32x4){0.f, 0.f, 0.f, 0.f};
        cur = nxt; cA = nA; cB = nB; ++ui;
        if (wr == 1) PG8_BAR;
    }
    PG8_WAIT_V(0);
    PG8_BAR;
#undef PG8_SA
#undef PG8_SB
#undef PG8_STAGE
#undef PG8_LDA
#undef PG8_LDB
#undef PG8_MMA
#undef PG8_WAIT_V
#undef PG8_WAIT_L
#undef PG8_BAR
#undef PG8_SCHED
}
}

#define XB_TMO      128
#define XB_XCNT(j)  (256  + 64 * (j))
#define XB_XSUB(j)  (1280 + 64 * (j))
#define XB_XGEN(j)  (2304 + 64 * (j))
#define XB_TOP      3328
#define XB_TOPGEN   3392
#define XCD_BAR_WORDS 3456
#define XB_SPIN_CAP (1u << 18)

__device__ __forceinline__ unsigned xb_ld(unsigned* p)              { return __hip_atomic_load(p, __ATOMIC_RELAXED, __HIP_MEMORY_SCOPE_AGENT); }
__device__ __forceinline__ unsigned xb_add(unsigned* p, unsigned v) { return __hip_atomic_fetch_add(p, v, __ATOMIC_RELAXED, __HIP_MEMORY_SCOPE_AGENT); }
__device__ __forceinline__ unsigned xb_xcc_id() { return (unsigned)__builtin_amdgcn_s_getreg((3 << 11) | 20) & 0xFu; }
#define XB_SPIN(cond, bar) do { unsigned _sp = 0; while (cond) { __builtin_amdgcn_s_sleep(1); \
    if ((++_sp & 255u) == 0u) { if (xb_ld(&(bar)[XB_TMO])) break; if (_sp > XB_SPIN_CAP) { atomicAdd(&(bar)[XB_TMO], 1u); break; } } } } while (0)

struct XcdBarrier {
    unsigned* bar; unsigned x;
    volatile LAS unsigned* st;
};

__device__ __forceinline__ XcdBarrier xcd_barrier_post(unsigned* bar, volatile LAS unsigned* st) {
    XcdBarrier b; b.bar = bar; b.x = xb_xcc_id(); b.st = st;
    if (threadIdx.x == 0) (void)xb_add(&bar[XB_XCNT(b.x)], 1u);
    return b;
}
__device__ __forceinline__ void xcd_barrier_complete(unsigned* bar, unsigned x, unsigned& nloc, unsigned& nx) {
    const unsigned G = gridDim.x * gridDim.y * gridDim.z;
    unsigned sum, cnt, mine, sp = 0u;
    for (;;) {
        sum = 0u; cnt = 0u; mine = 0u;
#pragma unroll
        for (unsigned j = 0; j < 16; ++j) { const unsigned c = xb_ld(&bar[XB_XCNT(j)]); sum += c; cnt += (c > 0u) ? 1u : 0u; mine = (j == x) ? c : mine; }
        if (sum == G) break;
        __builtin_amdgcn_s_sleep(1);
        if ((++sp & 255u) == 0u) { if (xb_ld(&bar[XB_TMO])) break; if (sp > XB_SPIN_CAP) { atomicAdd(&bar[XB_TMO], 1u); break; } }
    }
    nloc = mine > 0u ? mine : 1u; nx = cnt > 0u ? cnt : 1u;
}

__device__ __forceinline__ void xcd_barrier(const XcdBarrier& b) {
    asm volatile("s_waitcnt vmcnt(0)" ::: "memory");
    __syncthreads();
    if (threadIdx.x == 0) {
        unsigned* bar = b.bar;
        __builtin_amdgcn_s_waitcnt(0);
        unsigned nloc = b.st[0], nx = b.st[1];
        if (nloc == 0u) { xcd_barrier_complete(bar, b.x, nloc, nx); b.st[0] = nloc; b.st[1] = nx; }
        const unsigned old = xb_add(&bar[XB_XSUB(b.x)], 1u);
        const unsigned gen = old / nloc;
        if (old + 1u == (gen + 1u) * nloc) {
            __builtin_amdgcn_fence(__ATOMIC_RELEASE, "agent");
            asm volatile("s_waitcnt vmcnt(0)" ::: "memory");
            const unsigned og = xb_add(&bar[XB_TOP], 1u);
            const unsigned tg = og / nx;
            if (og + 1u == (tg + 1u) * nx) xb_add(&bar[XB_TOPGEN], 1u);
            else XB_SPIN(xb_ld(&bar[XB_TOPGEN]) == tg, bar);
            __builtin_amdgcn_fence(__ATOMIC_ACQUIRE, "agent");
            xb_add(&bar[XB_XGEN(b.x)], 1u);
            asm volatile("s_waitcnt vmcnt(0)" ::: "memory");
        } else {
            XB_SPIN(xb_ld(&bar[XB_XGEN(b.x)]) == gen, bar);
            __builtin_amdgcn_fence(__ATOMIC_ACQUIRE, "agent");
            asm volatile("s_waitcnt vmcnt(0)" ::: "memory");
        }
    }
    __syncthreads();
}

__device__ __forceinline__ void tr_item(const float* W, int N, int K, int k0, int n0, bf16_t* dst, LAS float* scr, int lane) {
#pragma unroll 8
    for (int i = 0; i < 32; ++i) { const int kk = 2 * i + (lane >> 5); scr[kk * 33 + (lane & 31)] = W[(size_t)(k0 + kk) * N + n0 + (lane & 31)]; }
    asm volatile("s_waitcnt lgkmcnt(0)" ::: "memory");
    const int c = lane & 7;
#pragma unroll
    for (int j = 0; j < 4; ++j) { const int n = (lane >> 3) + 8 * j; const LAS float* s = scr + (8 * c) * 33 + n;
        u32x4 o; o.x = cvtpk(s[0 * 33], s[1 * 33]); o.y = cvtpk(s[2 * 33], s[3 * 33]); o.z = cvtpk(s[4 * 33], s[5 * 33]); o.w = cvtpk(s[6 * 33], s[7 * 33]);
        *(u32x4*)(dst + (size_t)n * K + k0 + 8 * c) = o; }
    asm volatile("s_waitcnt lgkmcnt(0)" ::: "memory");
}

__device__ __forceinline__ void rms_row_bf16(const float* xrow, const float* g, bf16_t* orow, int lane) {
    const f32x4* xr = (const f32x4*)xrow + lane;
    f32x4 v[8]; float s = 0.f;
#pragma unroll
    for (int j = 0; j < 8; ++j) { v[j] = xr[64 * j]; s += (v[j].x * v[j].x + v[j].y * v[j].y) + (v[j].z * v[j].z + v[j].w * v[j].w); }
    const float r = 1.0f / sqrtf(wave_sum(s) * (1.0f / DM) + EPS);
    const f32x4* gr = (const f32x4*)g + lane;
    u32x2* o8 = (u32x2*)orow + lane;
#pragma unroll
    for (int j = 0; j < 8; ++j) { const f32x4 gv = gr[64 * j]; u32x2 w; w.x = cvtpk(v[j].x * r * gv.x, v[j].y * r * gv.y); w.y = cvtpk(v[j].z * r * gv.z, v[j].w * r * gv.w); o8[64 * j] = w; }
}

template <int PART>
__device__ __forceinline__ void prologue(const Params& p, LAS unsigned char* lds, int G, int blk) {
    const int tid = threadIdx.x, lane = tid & 63, wave = __builtin_amdgcn_readfirstlane(tid >> 6);
    LAS float* scr = (LAS float*)(lds + wave * 16384);
    const int gw = (PART == 0 ? blk : blk - G / 2) * 8 + wave, NGW = (PART == 0 ? G : G - G / 2) * 8;
    unsigned char* ws = p.ws;
    bf16_t* Wqk = (bf16_t*)(ws + WS_WQK); bf16_t* Wv = (bf16_t*)(ws + WS_WV); bf16_t* Wout = (bf16_t*)(ws + WS_WOUT);
    bf16_t* Wmkv = (bf16_t*)(ws + WS_WMKV); bf16_t* Wmo = (bf16_t*)(ws + WS_WMO); bf16_t* Wgu = (bf16_t*)(ws + WS_WGU); bf16_t* Wdn = (bf16_t*)(ws + WS_WDN);
    constexpr int I0 = 32 * 192, I1 = 32 * 64, I2 = 32 * 128, I3 = 32 * 64, I4 = 32 * 352, I5 = 88 * 64;
    constexpr int NA = I0 + I1 + I2 + I3, NIT = NA + I4 + I5;
    for (int it = (PART == 0 ? 0 : NA) + gw; it < (PART == 0 ? NA : NIT); it += NGW) {
        int r = it;
        if (r < I0) { const int kb = r / 192, nb = r % 192, n0 = nb * 32; bf16_t* dst;
            if (n0 < 2048) dst = Wqk + (size_t)n0 * 2048;
            else if (n0 < 3072) dst = Wv + (size_t)(n0 - 2048) * 2048;
            else if (n0 < 5120) dst = Wqk + (size_t)(2048 + n0 - 3072) * 2048;
            else dst = Wv + (size_t)(1024 + n0 - 5120) * 2048;
            tr_item(p.w_in, 6144, 2048, kb * 64, n0, dst, scr, lane); continue; }
        r -= I0;
        if (r < I1) { const int kb = r / 64, nb = r % 64; tr_item(p.w_out, 2048, 2048, kb * 64, nb * 32, Wout + (size_t)(nb * 32) * 2048, scr, lane); continue; }
        r -= I1;
        if (r < I2) { const int kb = r / 128, nb = r % 128; tr_item(p.w_mkv, 4096, 2048, kb * 64, nb * 32, Wmkv + (size_t)(nb * 32) * 2048, scr, lane); continue; }
        r -= I2;
        if (r < I3) { const int kb = r / 64, nb = r % 64; tr_item(p.w_mo, 2048, 2048, kb * 64, nb * 32, Wmo + (size_t)(nb * 32) * 2048, scr, lane); continue; }
        r -= I3;
        if (r < I4) { const int kb = r / 352, nb = r % 352, n0 = nb * 32; int drow;
            if (n0 < DFF) drow = 256 * (n0 / 128) + (n0 % 128); else { const int c2 = n0 - DFF; drow = 256 * (c2 / 128) + 128 + (c2 % 128); }
            tr_item(p.w_gu, 2 * DFF, 2048, kb * 64, n0, Wgu + (size_t)drow * 2048, scr, lane); continue; }
        r -= I4;
        { const int kb = r / 64, nb = r % 64; tr_item(p.w_down, 2048, DFF, kb * 64, nb * 32, Wdn + (size_t)(nb * 32) * DFF, scr, lane); }
    }
    if (PART == 1) return;
    { bf16_t* Wmq = (bf16_t*)(ws + WS_WMQ); const int gt = blk * 512 + tid, NGT = G * 512;
      for (int i = gt; i < 2048 * 2048 / 4; i += NGT) { const f32x4 v = ((const f32x4*)p.w_mq)[i]; u32x2 w; w.x = cvtpk(v.x, v.y); w.y = cvtpk(v.z, v.w); ((u32x2*)Wmq)[i] = w; } }
    bf16_t* H = (bf16_t*)(ws + WS_H); bf16_t* memn = (bf16_t*)(ws + WS_MEMN);
    for (int m = gw; m < MT; m += NGW) rms_row_bf16(p.x + (size_t)m * DM, p.g_mix_pre, H + (size_t)m * DM, lane);
    for (int m = gw; m < NB * 256; m += NGW) rms_row_bf16(p.mem + (size_t)m * DM, p.g_mem_kv, memn + (size_t)m * DM, lane);
}

template <bool HAS_H, bool XIN_BF, bool XOUT_BF>
__device__ __forceinline__ void row_pass(const bf16_t* y, const void* xin, void* xout, const float* g_post, const float* g_pre, bf16_t* hout, int G, int blk) {
    const int tid = threadIdx.x, lane = tid & 63, wave = tid >> 6;
    const int gw = blk * 8 + wave, NGW = G * 8;
    for (int row = gw; row < MT; row += NGW) {
        const u32x2* yr = (const u32x2*)(y + (size_t)row * DM) + lane;
        const f32x4* xr = (const f32x4*)((const float*)xin + (size_t)row * DM) + lane;
        const u32x2* xrb = (const u32x2*)((const bf16_t*)xin + (size_t)row * DM) + lane;
        f32x4 yv[8], xv[8]; float s = 0.f;
#pragma unroll
        for (int j = 0; j < 8; ++j) { const u32x2 w = yr[64 * j]; yv[j] = (f32x4){bf_lo(w.x), bf_hi(w.x), bf_lo(w.y), bf_hi(w.y)};
            if (XIN_BF) { const u32x2 xw = xrb[64 * j]; xv[j] = (f32x4){bf_lo(xw.x), bf_hi(xw.x), bf_lo(xw.y), bf_hi(xw.y)}; } else xv[j] = xr[64 * j];
            s += (yv[j].x * yv[j].x + yv[j].y * yv[j].y) + (yv[j].z * yv[j].z + yv[j].w * yv[j].w); }
        const float r = 1.0f / sqrtf(wave_sum(s) * (1.0f / DM) + EPS);
        const f32x4* gp = (const f32x4*)g_post + lane;
        f32x4* xo = (f32x4*)((float*)xout + (size_t)row * DM) + lane;
        u32x2* xob = (u32x2*)((bf16_t*)xout + (size_t)row * DM) + lane;
        float s1 = 0.f;
#pragma unroll
        for (int j = 0; j < 8; ++j) { const f32x4 gv = gp[64 * j]; xv[j] = xv[j] + yv[j] * r * gv;
            if (XOUT_BF) { u32x2 w; w.x = cvtpk(xv[j].x, xv[j].y); w.y = cvtpk(xv[j].z, xv[j].w); xob[64 * j] = w; } else xo[64 * j] = xv[j];
            s1 += (xv[j].x * xv[j].x + xv[j].y * xv[j].y) + (xv[j].z * xv[j].z + xv[j].w * xv[j].w); }
        if (HAS_H) {
            const float r1 = 1.0f / sqrtf(wave_sum(s1) * (1.0f / DM) + EPS);
            const f32x4* gq = (const f32x4*)g_pre + lane;
            u32x2* ho = (u32x2*)(hout + (size_t)row * DM) + lane;
#pragma unroll
            for (int j = 0; j < 8; ++j) { const f32x4 gv = gq[64 * j]; u32x2 w; w.x = cvtpk(xv[j].x * r1 * gv.x, xv[j].y * r1 * gv.y); w.y = cvtpk(xv[j].z * r1 * gv.z, xv[j].w * r1 * gv.w); ho[64 * j] = w; }
        }
    }
}

__device__ __forceinline__ void softmax_pass(const float* S, bf16_t* P, int G, int blk) {
    const int tid = threadIdx.x, lane = tid & 63, wave = tid >> 6;
    const int gw = blk * 8 + wave, NGW = G * 8;
    for (int row = gw; row < MT; row += NGW) {
        const f32x4* sr = (const f32x4*)(S + (size_t)row * 1024) + lane;
        u32x2* pr = (u32x2*)(P + (size_t)row * 1024) + lane;
        f32x4 v[4];
#pragma unroll
        for (int h = 0; h < 4; ++h) v[h] = sr[64 * h];
#pragma unroll
        for (int h = 0; h < 4; ++h) {
            const float mx = wave_max(fmaxf(fmaxf(v[h].x, v[h].y), fmaxf(v[h].z, v[h].w)));
            f32x4 e; e.x = ex2(v[h].x - mx); e.y = ex2(v[h].y - mx); e.z = ex2(v[h].z - mx); e.w = ex2(v[h].w - mx);
            const float inv = 1.0f / wave_sum((e.x + e.y) + (e.z + e.w));
            u32x2 w; w.x = cvtpk(e.x * inv, e.y * inv); w.y = cvtpk(e.z * inv, e.w * inv); pr[64 * h] = w;
        }
    }
}

#ifndef PROBE_DIFF_REPS
#define PROBE_DIFF_REPS 1
#endif
#ifndef PROBE_SB_REPS
#define PROBE_SB_REPS 1
#endif
constexpr int A_KBUF = 16384, A_VBUF = 16384, A_KOFF = 0, A_VOFF = 2 * A_KBUF, A_TAB = A_VOFF + 2 * A_VBUF, A_FLAG = A_TAB + 1024;
#define MFMA32(a, b, c) __builtin_amdgcn_mfma_f32_32x32x16_bf16((a), (b), (c), 0, 0, 0)
#define SCHEDB() __builtin_amdgcn_sched_barrier(0)
__device__ __forceinline__ int crow(int r, int h) { return (r & 3) + 8 * (r >> 2) + 4 * h; }

template <int KD>
__device__ __forceinline__ void tile_dma(const bf16_t* Kg, const bf16_t* Vg, LAS unsigned char* kb, LAS unsigned char* vb, int wid, int lane) {
    if (KD == 128) {
#pragma unroll
        for (int i = 0; i < 2; ++i) {
            const int kc = wid * 2 + i, rho = 4 * kc + (lane >> 4), x = lane & 15, i5 = rho & 31;
            const int key = (rho & 32) + 16 * ((i5 >> 2) & 1) + 8 * (i5 >> 4) + 4 * ((i5 >> 3) & 1) + (i5 & 3);
            const bf16_t* src = Kg + (size_t)key * KD + ((x ^ (rho & 15)) * 8);
            __builtin_amdgcn_global_load_lds((const unsigned*)src, (LAS unsigned*)(kb + kc * 1024), 16, 0, 0);
        }
    } else {
        const int kc = wid, rho = 8 * kc + (lane >> 3), x = lane & 7, i5 = rho & 31;
        const int key = (rho & 32) + 16 * ((i5 >> 2) & 1) + 8 * (i5 >> 4) + 4 * ((i5 >> 3) & 1) + (i5 & 3);
        const bf16_t* src = Kg + (size_t)key * KD + ((x ^ ((rho >> 1) & 7)) * 8);
        __builtin_amdgcn_global_load_lds((const unsigned*)src, (LAS unsigned*)(kb + kc * 1024), 16, 0, 0);
    }
#pragma unroll
    for (int i = 0; i < 2; ++i) {
        const int vc = wid * 2 + i, rho = 8 * vc + (lane >> 3), x = lane & 7;
        const bf16_t* src = Vg + (size_t)rho * 64 + ((x ^ ((rho >> 1) & 7)) * 8);
        __builtin_amdgcn_global_load_lds((const unsigned*)src, (LAS unsigned*)(vb + vc * 1024), 16, 0, 0);
    }
}
__device__ __forceinline__ bf16x8 pack8(const f32x16& s, int o) {
    u32x4 w; w.x = cvtpk(s[o], s[o + 1]); w.y = cvtpk(s[o + 2], s[o + 3]); w.z = cvtpk(s[o + 4], s[o + 5]); w.w = cvtpk(s[o + 6], s[o + 7]);
    return __builtin_bit_cast(bf16x8, w);
}
__device__ __forceinline__ void pv_acc(f32x16 (&O)[4], const f32x16& s0, const f32x16& s1, const LAS unsigned char* vbase, int xv) {
#pragma unroll
    for (int g = 0; g < 4; ++g) {
        const int kbk = g >> 1, s = g & 1;
        const int co = ((4 * kbk + s) ^ xv) << 4;
        bf16x8 vf[4];
#pragma unroll
        for (int db = 0; db < 4; ++db) vf[db] = *(const LAS bf16x8*)(vbase + db * 4096 + co);
        const bf16x8 pf = pack8(kbk ? s1 : s0, 8 * s);
#pragma unroll
        for (int db = 0; db < 4; ++db) O[db] = MFMA32(pf, vf[db], O[db]);
        SCHEDB();
    }
}
template <int NKS, int ROWB>
__device__ __forceinline__ void qk_tile(f32x16& s0, f32x16& s1, const LAS unsigned char* kb, int xk, const bf16x8* qf) {
    bf16x8 a[2][2];
    { const int co = (0 ^ xk) << 4; a[0][0] = *(const LAS bf16x8*)(kb + co); a[0][1] = *(const LAS bf16x8*)(kb + 32 * ROWB + co); }
#pragma unroll
    for (int ks = 0; ks < NKS; ++ks) {
        if (ks + 1 < NKS) { const int co = ((2 * (ks + 1)) ^ xk) << 4; a[(ks + 1) & 1][0] = *(const LAS bf16x8*)(kb + co); a[(ks + 1) & 1][1] = *(const LAS bf16x8*)(kb + 32 * ROWB + co); }
        s0 = MFMA32(a[ks & 1][0], qf[ks], s0); s1 = MFMA32(a[ks & 1][1], qf[ks], s1);
        SCHEDB();
    }
}

__device__ __forceinline__ void smax_update(f32x16& s0, f32x16& s1, float& m, float& l, f32x16 (&O)[4], int hh) {
    float mx = fmaxf(s0[0], s1[0]);
#pragma unroll
    for (int r = 1; r < 16; ++r) mx = fmaxf(mx, fmaxf(s0[r], s1[r]));
    mx = fmaxf(mx, __shfl_xor(mx, 32));
    if (__any(mx > m + 8.0f)) {
        const float mn = fmaxf(m, mx);
        const float alpha = ex2(m - mn);
        l *= alpha; m = mn;
        int hl = hh; asm volatile("" : "+v"(hl));
#pragma unroll
        for (int r = 0; r < 16; ++r) { const float a = __shfl(alpha, crow(r, hl));
#pragma unroll
            for (int db = 0; db < 4; ++db) O[db][r] *= a; }
    }
    float sum = 0.f;
#pragma unroll
    for (int r = 0; r < 16; ++r) { s0[r] = ex2(s0[r] - m); s1[r] = ex2(s1[r] - m); sum += s0[r] + s1[r]; }
    l += sum;
}

#define MX3(a, b, c) __builtin_fmaxf(__builtin_fmaxf((a), (b)), (c))
__device__ __forceinline__ void diff_unit(const Params& p, LAS unsigned char* lds, int b, int h, int qb, float lam) {
    int tid_ = threadIdx.x; asm volatile("" : "+v"(tid_));
    const int tid = tid_, lane = tid & 63, wid = __builtin_amdgcn_readfirstlane(tid >> 6), c = lane & 31, hh = lane >> 5;
    const bf16_t* QK = (const bf16_t*)(p.ws + WS_QK); const bf16_t* VT = (const bf16_t*)(p.ws + WS_VT); bf16_t* AO = (bf16_t*)(p.ws + WS_AO);
    const size_t rowbase = (size_t)b * SEQ;
    const int q0 = qb * 256 + wid * 32, mylast = q0 >> 6, NT = 4 * qb + 4;
    const int xk = ((c >> 1) & 7) ^ hh, xv = ((c >> 1) & 7) ^ (2 * hh);
    LAS float* tab = (LAS float*)(lds + A_TAB);
    if (tid < 256) { const int d = tid - 64, n = d < 0 ? -d : d; int bk = (n < 8) ? n : min(15, 2 + (31 - __clz(n * n))); if (d < 0) bk += 16;
        tab[tid] = (p.rel_bias[bk * 8 + h] - p.rel_bias[15 * 8 + h]) * LOG2E; }
    const bf16_t* Vg0 = VT + ((size_t)h * 512 + (size_t)b * 64) * 8192;
    unsigned* park = (unsigned*)(p.ws + WS_PARK) + ((size_t)(blockIdx.x * 8 + wid) * 32) * 64 + lane;
    const bf16x8 ones = (bf16x8){0x3f80, 0x3f80, 0x3f80, 0x3f80, 0x3f80, 0x3f80, 0x3f80, 0x3f80};
    f32x16 O[4];
#pragma unroll
    for (int mp = 0; mp < 2; ++mp) {
        const bf16_t* Kg0 = (const bf16_t*)(p.ws + WS_KD) + ((size_t)(2 * h + mp) * MT + rowbase) * 64;
        tile_dma<64>(Kg0, Vg0, lds + A_KOFF, lds + A_VOFF, wid, lane);
        const bf16_t* qp = QK + (rowbase + q0 + c) * 4096 + h * 128 + 64 * mp + hh * 8;
        bf16x8 qf[4];
#pragma unroll
        for (int ks = 0; ks < 4; ++ks) qf[ks] = *(const bf16x8*)(qp + 16 * ks);
#pragma unroll
        for (int db = 0; db < 4; ++db) O[db] = (f32x16){};
        f32x16 L = (f32x16){};
        f32x16 negm = (f32x16){};
        float m = 0.f;
        asm volatile("s_waitcnt vmcnt(0)" ::: "memory");
        __syncthreads();
        for (int jt = 0; jt < NT; ++jt) {
            const int cur = jt & 1;
            if (jt + 1 < NT) tile_dma<64>(Kg0 + (size_t)(jt + 1) * 4096, Vg0 + (size_t)(jt + 1) * 8192, lds + A_KOFF + (cur ^ 1) * A_KBUF, lds + A_VOFF + (cur ^ 1) * A_VBUF, wid, lane);
            if (jt <= mylast) {
                const LAS unsigned char* kb = lds + A_KOFF + cur * A_KBUF + c * 128;
                const LAS unsigned char* vb = lds + A_VOFF + cur * A_VBUF + c * 128;
                f32x16 s0, s1;
                {
                    bf16x8 a[2][2];
                    { const int co = (0 ^ xk) << 4; a[0][0] = *(const LAS bf16x8*)(kb + co); a[0][1] = *(const LAS bf16x8*)(kb + 4096 + co); }
#pragma unroll
                    for (int ks = 0; ks < 4; ++ks) {
                        if (ks + 1 < 4) { const int co = ((2 * (ks + 1)) ^ xk) << 4; a[(ks + 1) & 1][0] = *(const LAS bf16x8*)(kb + co); a[(ks + 1) & 1][1] = *(const LAS bf16x8*)(kb + 4096 + co); }
                        if (ks == 0) { s0 = MFMA32(a[0][0], qf[0], negm); s1 = MFMA32(a[0][1], qf[0], negm); }
                        else { s0 = MFMA32(a[ks & 1][0], qf[ks], s0); s1 = MFMA32(a[ks & 1][1], qf[ks], s1); }
                        SCHEDB();
                    }
                }
                if ((q0 - (64 * jt + 63)) < 91) {
                    const int idx0 = (q0 + c) - (64 * jt + 16 * hh) + 64;
#pragma unroll
                    for (int r = 0; r < 16; ++r) { s0[r] += tab[min(idx0 - r, 255)]; s1[r] += tab[min(idx0 - 32 - r, 255)]; if ((r & 3) == 3) SCHEDB(); }
                }
                float mx;
                { float a0 = MX3(s0[0], s0[1], s1[0]), a1 = MX3(s0[2], s0[3], s1[1]); a0 = MX3(a0, s1[2], s1[3]);
#pragma unroll
                  for (int r = 4; r < 16; r += 4) { a0 = MX3(a0, s0[r], s0[r + 1]); a1 = MX3(a1, s0[r + 2], s0[r + 3]); a0 = MX3(a0, s1[r], s1[r + 1]); a1 = MX3(a1, s1[r + 2], s1[r + 3]); }
                  mx = fmaxf(a0, a1); }
                { auto rr = __builtin_amdgcn_permlane32_swap(__float_as_uint(mx), __float_as_uint(mx), false, false); mx = fmaxf(__uint_as_float(rr[0]), __uint_as_float(rr[1])); }
                const bool first = (jt == 0);
                if (first || __any(mx > 8.0f)) {
                    const float dl = first ? mx : fmaxf(mx, 0.f);
                    m += dl;
#pragma unroll
                    for (int r = 0; r < 16; ++r) { s0[r] -= dl; s1[r] -= dl; }
#pragma unroll
                    for (int r = 0; r < 16; ++r) negm[r] = -m;
                    if (!first) {
                        const float alpha = ex2(-dl);
                        int hl = hh; asm volatile("" : "+v"(hl));
#pragma unroll
                        for (int r = 0; r < 16; ++r) { const float a = __shfl(alpha, crow(r, hl)); L[r] *= a;
#pragma unroll
                            for (int db = 0; db < 4; ++db) O[db][r] *= a; }
                    }
                }
#pragma unroll
                for (int r = 0; r < 16; ++r) s0[r] = ex2(s0[r]);
#pragma unroll
                for (int g = 0; g < 4; ++g) {
                    const int co = ((4 * (g >> 1) + (g & 1)) ^ xv) << 4;
                    bf16x8 vf[4];
#pragma unroll
                    for (int db = 0; db < 4; ++db) vf[db] = *(const LAS bf16x8*)(vb + db * 4096 + co);
                    const bf16x8 pf = pack8((g >> 1) ? s1 : s0, 8 * (g & 1));
#pragma unroll
                    for (int db = 0; db < 4; ++db) O[db] = MFMA32(pf, vf[db], O[db]);
                    L = MFMA32(pf, ones, L);
                    if (g < 2) {
#pragma unroll
                        for (int r = 0; r < 8; ++r) s1[8 * g + r] = ex2(s1[8 * g + r]);
                    }
                    SCHEDB();
                }
            }
            asm volatile("s_waitcnt vmcnt(0)" ::: "memory");
            __syncthreads();
        }
#pragma unroll
        for (int r = 0; r < 16; ++r) { const float a = (mp == 0 ? 1.0f : lam) / L[r];
#pragma unroll
            for (int db = 0; db < 4; ++db) O[db][r] *= a; }
        if (mp == 0) {
#pragma unroll
            for (int db = 0; db < 4; ++db)
#pragma unroll
                for (int j = 0; j < 8; ++j) park[(db * 8 + j) * 64] = cvtpk(O[db][2 * j], O[db][2 * j + 1]);
        }
    }
    float gn[4];
#pragma unroll
    for (int db = 0; db < 4; ++db) gn[db] = p.diff_gain[32 * db + c] * 0.8f;
#pragma unroll
    for (int r = 0; r < 16; ++r) {
        const int qr = crow(r, hh);
        float o[4]; float ss = 0.f;
#pragma unroll
        for (int db = 0; db < 4; ++db) { const unsigned w = park[(db * 8 + (r >> 1)) * 64]; o[db] = ((r & 1) ? bf_hi(w) : bf_lo(w)) - O[db][r]; ss += o[db] * o[db]; }
#pragma unroll
        for (int off = 1; off < 32; off <<= 1) ss += __shfl_xor(ss, off);
        const float rs = 1.0f / sqrtf(ss * (1.0f / 128.0f) + EPS);
        bf16_t* op = AO + (rowbase + q0 + qr) * DM + h * 128 + c;
#pragma unroll
        for (int db = 0; db < 4; ++db) op[32 * db] = (bf16_t)(cvtpk(o[db] * rs * gn[db], 0.f) & 0xffffu);
    }
}
#undef MX3

__device__ __forceinline__ void sb_unit(const Params& p, LAS unsigned char* lds, int b, int h, int qb) {
    int tid_ = threadIdx.x; asm volatile("" : "+v"(tid_));
    const int tid = tid_, lane = tid & 63, wid = __builtin_amdgcn_readfirstlane(tid >> 6), c = lane & 31, hh = lane >> 5;
    const bf16_t* QK = (const bf16_t*)(p.ws + WS_QK); const bf16_t* VT = (const bf16_t*)(p.ws + WS_VT); bf16_t* AO = (bf16_t*)(p.ws + WS_AO);
    const size_t rowbase = (size_t)b * SEQ;
    const int q0 = qb * 256 + wid * 32, mylast = q0 >> 6, T0 = 4 * qb + 3;
    const int xk = (c & 15) ^ hh, xv = ((c >> 1) & 7) ^ (2 * hh);
    LAS unsigned* flag = (LAS unsigned*)(lds + A_FLAG);
    const bf16_t* Kg0 = (const bf16_t*)(p.ws + WS_KS) + ((size_t)h * MT + rowbase) * 128;
    const bf16_t* Vg0 = VT + ((size_t)(8 + h) * 512 + (size_t)b * 64) * 8192;
    tile_dma<128>(Kg0 + (size_t)T0 * 8192, Vg0 + (size_t)T0 * 8192, lds + A_KOFF, lds + A_VOFF, wid, lane);
    const bf16_t* qp = QK + (rowbase + q0 + c) * 4096 + 2048 + h * 128 + hh * 8;
    bf16x8 qf[8];
#pragma unroll
    for (int ks = 0; ks < 8; ++ks) qf[ks] = *(const bf16x8*)(qp + 16 * ks);
    f32x16 O[4];
#pragma unroll
    for (int db = 0; db < 4; ++db) O[db] = (f32x16){};
    float carry = 0.f; bool done = false;
    asm volatile("s_waitcnt vmcnt(0)" ::: "memory");
    __syncthreads();
    for (int jt = T0; jt >= 0; --jt) {
        const int cur = (T0 - jt) & 1;
        if (jt > 0) tile_dma<128>(Kg0 + (size_t)(jt - 1) * 8192, Vg0 + (size_t)(jt - 1) * 8192, lds + A_KOFF + (cur ^ 1) * A_KBUF, lds + A_VOFF + (cur ^ 1) * A_VBUF, wid, lane);
        if (jt <= mylast && !done) {
            const LAS unsigned char* kb = lds + A_KOFF + cur * A_KBUF + c * 256;
            const LAS unsigned char* vb = lds + A_VOFF + cur * A_VBUF + c * 128;
            f32x16 s0 = (f32x16){}, s1 = (f32x16){};
            qk_tile<8, 256>(s0, s1, kb, xk, qf);
            const bool diag = (jt == mylast);
            const int lim = (q0 + c) - (64 * jt + 16 * hh);
            float run = 0.f;
#pragma unroll
            for (int r = 15; r >= 0; --r) {
                const float z = s1[r]; const float sp = fmaxf(z, 0.f) + lg2(1.0f + ex2(-fabsf(z)));
                float lk = -sp, lb = z - sp;
                if (diag && !(r + 32 < lim)) { lk = 0.f; lb = -1e30f; }
                s1[r] = lb + run; run += lk;
            }
            const float T1 = run; run = 0.f;
#pragma unroll
            for (int r = 15; r >= 0; --r) {
                const float z = s0[r]; const float sp = fmaxf(z, 0.f) + lg2(1.0f + ex2(-fabsf(z)));
                float lk = -sp, lb = z - sp;
                if (diag && !(r < lim)) { lk = 0.f; lb = -1e30f; }
                s0[r] = lb + run; run += lk;
            }
            const float T0s = run;
            const float T1p = __shfl_xor(T1, 32), T0p = __shfl_xor(T0s, 32);
            const float off1 = carry + (hh ? 0.f : T1p);
            const float off0 = carry + T1 + T1p + (hh ? 0.f : T0p);
#pragma unroll
            for (int r = 0; r < 16; ++r) { s1[r] = ex2(s1[r] + off1); s0[r] = ex2(s0[r] + off0); }
            carry += (T1 + T1p) + (T0s + T0p);
            pv_acc(O, s0, s1, vb, xv);
            done = __all(carry < -60.0f);
        }
        if (lane == 0) flag[cur * 8 + wid] = done ? 1u : 0u;
        asm volatile("s_waitcnt vmcnt(0)" ::: "memory");
        __syncthreads();
        const u32x4 f0 = *(const LAS u32x4*)(flag + cur * 8), f1 = *(const LAS u32x4*)(flag + cur * 8 + 4);
        if ((f0.x & f0.y & f0.z & f0.w & f1.x & f1.y & f1.z & f1.w) != 0u) break;
    }
    float gn[4];
#pragma unroll
    for (int db = 0; db < 4; ++db) gn[db] = p.sb_gain[32 * db + c];
#pragma unroll
    for (int r = 0; r < 16; ++r) {
        const int qr = crow(r, hh);
        float ss = 0.f;
#pragma unroll
        for (int db = 0; db < 4; ++db) ss += O[db][r] * O[db][r];
#pragma unroll
        for (int off = 1; off < 32; off <<= 1) ss += __shfl_xor(ss, off);
        const float rs = 1.0f / sqrtf(ss * (1.0f / 128.0f) + EPS);
        bf16_t* op = AO + (rowbase + q0 + qr) * DM + 1024 + h * 128 + c;
#pragma unroll
        for (int db = 0; db < 4; ++db) op[32 * db] = (bf16_t)(cvtpk(O[db][r] * rs * gn[db], 0.f) & 0xffffu);
    }
    asm volatile("s_waitcnt vmcnt(0)" ::: "memory");
    __syncthreads();
}

__device__ __forceinline__ void attention_phase(const Params& p, LAS unsigned char* lds, int G, int blk) {
    float s1 = 0.f, s2 = 0.f;
    for (int i = 0; i < 64; ++i) { s1 += p.lq1[i] * p.lk1[i]; s2 += p.lq2[i] * p.lk2[i]; }
    const float lam = expf(s1) - expf(s2) + 0.2f;
    const int v = (G % 8 == 0) ? (blk % 8) * (G / 8) + blk / 8 : blk;
    for (int rep = 0; rep < PROBE_DIFF_REPS; ++rep)
    for (int u = v; u < 1024; u += G) {
        const int bh = (u & 255) >> 2, s = u & 3, i = u >> 8;
        const int qb = (i == 0) ? s : (i == 1) ? 7 - s : (i == 2) ? 8 + s : 15 - s;
#ifndef NO_DIFF
        diff_unit(p, lds, bh >> 3, bh & 7, qb, lam);
#endif
    }
    for (int rep = 0; rep < PROBE_SB_REPS; ++rep)
    for (int u = v; u < 1024; u += G) {
        const int bh = (u & 255) >> 2, s = u & 3, i = u >> 8;
        const int qb = (i == 0) ? s : (i == 1) ? 7 - s : (i == 2) ? 8 + s : 15 - s;
#ifndef NO_SB
        sb_unit(p, lds, bh >> 3, bh & 7, qb);
#endif
    }
}

constexpr int LDS_BYTES = 143360;

__global__ void __launch_bounds__(512) fwd_megakernel(Params p) {
    extern __shared__ __attribute__((aligned(16))) unsigned char lds_raw[];
    LAS unsigned char* lds = (LAS unsigned char*)lds_raw;
    cg::grid_group grid = cg::this_grid();
    const int G = gridDim.x, blk = blockIdx.x;
    unsigned char* ws = p.ws;

#ifdef ONLY_GEMM
#define GEMM(gi) do { if (gi == ONLY_GEMM) pg8::gemm_phase<gi>(lds, ws, G, blk); } while (0)
#else
#define GEMM(gi) pg8::gemm_phase<gi>(lds, ws, G, blk)
#endif
    volatile LAS unsigned* xst = (volatile LAS unsigned*)(lds + 131072);
    unsigned* barw = (unsigned*)ws;
    if (threadIdx.x < 2) xst[threadIdx.x] = 0u;
    if (blk == 0) for (int i = threadIdx.x; i < XCD_BAR_WORDS; i += 512) barw[i] = 0u;
    prologue<0>(p, lds, G, blk);
#ifdef PROBE_PRO2
    __syncthreads(); prologue<0>(p, lds, G, blk);
#endif
    grid.sync();
    XcdBarrier xbar = xcd_barrier_post(barw, xst);
    GEMM(0); GEMM(1); GEMM(2);
    if (blk >= G / 2) prologue<1>(p, lds, G, blk);
#ifdef PROBE_G012
    GEMM(0); GEMM(1); GEMM(2);
#endif
    GSYNC();
    attention_phase(p, lds, G, blk); GSYNC();
    GEMM(3); GEMM(4); GEMM(5); GSYNC();
    row_pass<true, false, true>((const bf16_t*)(ws + WS_MIX), p.x, ws + WS_XR, p.g_mix_post, p.g_mem_pre, (bf16_t*)(ws + WS_H), G, blk);
#ifdef PROBE_R12
    row_pass<true, false, true>((const bf16_t*)(ws + WS_MIX), p.x, ws + WS_XR, p.g_mix_post, p.g_mem_pre, (bf16_t*)(ws + WS_H), G, blk);
#endif
    GSYNC();
    GEMM(6); GSYNC();
    GEMM(7); GSYNC();
    row_pass<true, true, true>((const bf16_t*)(ws + WS_MEMO), ws + WS_XR, ws + WS_XR, p.g_mem_post, p.g_ffn_pre, (bf16_t*)(ws + WS_H), G, blk); GSYNC();
    GEMM(8);
#ifdef PROBE_G8
    GEMM(8);
#endif
    GSYNC();
    GEMM(9);
#ifdef PROBE_G9
    GEMM(9);
#endif
    GSYNC();
    row_pass<false, true, false>((const bf16_t*)(ws + WS_FO), ws + WS_XR, p.out, p.g_ffn_post, nullptr, nullptr, G, blk);
#undef GEMM
}

extern "C" void kernel_launch(void* const* d_in, const int* in_sizes, int n_in, void* d_out, int out_size, void* d_ws, size_t ws_size, hipStream_t stream) {
    static int grid_blocks = 0;
    if (grid_blocks == 0) {
        if (n_in != 23 || ws_size < WS_END) { fprintf(stderr, "kernel_launch: unexpected n_in %d / ws %zu\n", n_in, ws_size); grid_blocks = -1; return; }
        int dev = 0, cus = 0, per_cu = 0;
        hipGetDevice(&dev);
        hipDeviceGetAttribute(&cus, hipDeviceAttributeMultiprocessorCount, dev);
        if (hipFuncSetAttribute((const void*)fwd_megakernel, hipFuncAttributeMaxDynamicSharedMemorySize, LDS_BYTES) != hipSuccess) { fprintf(stderr, "kernel_launch: hipFuncSetAttribute failed\n"); }
        if (hipOccupancyMaxActiveBlocksPerMultiprocessor(&per_cu, (const void*)fwd_megakernel, 512, LDS_BYTES) != hipSuccess || per_cu < 1) { fprintf(stderr, "kernel_launch: occupancy query gave %d\n", per_cu); per_cu = 1; }
        (void)hipGetLastError();
        grid_blocks = cus * 1;
        if (grid_blocks > 256) grid_blocks = 256;
    }
    if (grid_blocks < 0) return;
    Params p{};
    const float* const* in = (const float* const*)d_in;
    p.x = in[0]; p.mem = in[1]; p.w_in = in[2]; p.w_out = in[3]; p.rel_bias = in[4];
    p.lq1 = in[5]; p.lk1 = in[6]; p.lq2 = in[7]; p.lk2 = in[8];
    p.diff_gain = in[9]; p.sb_gain = in[10]; p.g_mix_pre = in[11]; p.g_mix_post = in[12];
    p.w_mq = in[13]; p.w_mkv = in[14]; p.w_mo = in[15]; p.g_mem_kv = in[16]; p.g_mem_pre = in[17]; p.g_mem_post = in[18];
    p.w_gu = in[19]; p.w_down = in[20]; p.g_ffn_pre = in[21]; p.g_ffn_post = in[22];
    p.out = (float*)d_out; p.ws = (unsigned char*)d_ws;
    void* args[] = {&p};
    hipError_t e = hipLaunchCooperativeKernel((const void*)fwd_megakernel, dim3(grid_blocks), dim3(512), args, LDS_BYTES, stream);
    if (e != hipSuccess) fprintf(stderr, "cooperative launch failed: %s (grid %d)\n", hipGetErrorString(e), grid_blocks);
}
```

```cpp
#define USE_NT 1
#define GSYNC() xcd_barrier(xbar)
#include <hip/hip_runtime.h>
#include <hip/hip_cooperative_groups.h>
#include <cstdint>
#include <cstdio>
namespace cg = cooperative_groups;

#define LAS __attribute__((address_space(3)))
typedef unsigned short bf16_t;
typedef short bf16x8 __attribute__((ext_vector_type(8)));
typedef float f32x4 __attribute__((ext_vector_type(4)));
typedef float f32x16 __attribute__((ext_vector_type(16)));
typedef unsigned u32x4 __attribute__((ext_vector_type(4)));
typedef unsigned u32x2 __attribute__((ext_vector_type(2)));
typedef float f32x2_t __attribute__((ext_vector_type(2)));
typedef __bf16 bf16x2_t __attribute__((ext_vector_type(2)));

constexpr int NB = 8, SEQ = 4096, DM = 2048, MT = NB * SEQ, DFF = 5632;
constexpr float LOG2E = 1.4426950408889634f;
constexpr float EPS = 1e-6f;
constexpr size_t MiB = 1u << 20;
constexpr size_t WS_WQK = 2 * MiB, WS_WV = 18 * MiB, WS_WOUT = 26 * MiB, WS_WMQ = 34 * MiB, WS_WMKV = 42 * MiB, WS_WMO = 58 * MiB,
                 WS_WGU = 66 * MiB, WS_WDN = 110 * MiB, WS_MEMN = 132 * MiB, WS_KVM = 140 * MiB, WS_WKT = 156 * MiB, WS_VWT = 188 * MiB,
                 WS_H = 224 * MiB, WS_QK = 352 * MiB, WS_VT = 608 * MiB, WS_AO = 736 * MiB, WS_MIX = 352 * MiB, WS_S = 480 * MiB,
                 WS_P = 608 * MiB, WS_MEMO = 672 * MiB, WS_F = 352 * MiB, WS_FO = 704 * MiB, WS_KD = 864 * MiB, WS_KS = 928 * MiB, WS_XR = 864 * MiB  , WS_PARK = 992 * MiB, WS_END = 1008 * MiB;

struct Params {
    const float* x; const float* mem; const float* w_in; const float* w_out; const float* rel_bias;
    const float* lq1; const float* lk1; const float* lq2; const float* lk2;
    const float* diff_gain; const float* sb_gain; const float* g_mix_pre; const float* g_mix_post;
    const float* w_mq; const float* w_mkv; const float* w_mo; const float* g_mem_kv; const float* g_mem_pre; const float* g_mem_post;
    const float* w_gu; const float* w_down; const float* g_ffn_pre; const float* g_ffn_post;
    float* out; unsigned char* ws;
};

__device__ __forceinline__ unsigned cvtpk(float lo, float hi) { f32x2_t v = {lo, hi}; bf16x2_t b = __builtin_convertvector(v, bf16x2_t); return __builtin_bit_cast(unsigned, b); }
#ifdef USE_NT
#define NTL(p) __builtin_nontemporal_load(&(p))
#define NTS(v, p) __builtin_nontemporal_store((v), &(p))
#else
#define NTL(p) (p)
#define NTS(v, p) ((p) = (v))
#endif
__device__ __forceinline__ float bf_lo(unsigned u) { return __uint_as_float(u << 16); }
__device__ __forceinline__ float bf_hi(unsigned u) { return __uint_as_float(u & 0xffff0000u); }
__device__ __forceinline__ float wave_sum(float v) {
#pragma unroll
    for (int o = 1; o < 64; o <<= 1) v += __shfl_xor(v, o);
    return v;
}
__device__ __forceinline__ float wave_max(float v) {
#pragma unroll
    for (int o = 1; o < 64; o <<= 1) v = fmaxf(v, __shfl_xor(v, o));
    return v;
}
__device__ __forceinline__ float ex2(float v) { return __builtin_amdgcn_exp2f(v); }
__device__ __forceinline__ float lg2(float v) { return __builtin_amdgcn_logf(v); }

namespace pg8 {
constexpr int BM = 256, BK = 64, HALF = 128, HTB = HALF * BK * 2, STAGE_BYTES = 8 * HTB;
__device__ __forceinline__ int lds_byte(int r, int c) { const int st = (r >> 4) * 2 + (c >> 5), rr = r & 15, cc = c & 31, ob = rr * 64 + cc * 2; return st * 1024 + (ob ^ (((ob >> 9) & 1) << 5)); }
__device__ __forceinline__ void stage_rc(int b, int& R, int& C) { const int st = b / 1024, sb = b % 1024, swz = sb ^ (((sb >> 9) & 1) << 5); R = (st >> 1) * 16 + swz / 64; C = (st & 1) * 32 + (swz % 64) / 2; }
__device__ __forceinline__ int perm32(int rho) { const int n = rho >> 4, i = rho & 15; return 8 * (i >> 2) + 4 * n + (i & 3); }

struct GUnit { const char* A; const char* B; char* C; int SA, SR, SB, SX; float scale; };

struct GemmDesc {
    size_t A, B, C;
    int K, lda, ldb, ldc;
    int nM, nN;
    int kind, mode;
    int scale_kind;
    float scale;
    size_t a_tile, b_tile, b_batch, c_rt, c_ct;
    size_t a_b, a_h, a_t, b_b, b_h, b_t, c_b, c_h, c_t;
};

constexpr GemmDesc make_desc(int gi) {
    GemmDesc d{};
    d.scale = 1.0f; d.kind = 0; d.mode = 0; d.scale_kind = 0;
    switch (gi) {
    case 0:
        d.A = WS_H; d.B = WS_WQK; d.C = WS_QK;
        d.K = 2048; d.lda = 2048; d.ldb = 2048; d.ldc = 4096; d.nM = 128; d.nN = 16; d.scale_kind = 1;
        d.a_tile = (size_t)256 * 2048 * 2; d.b_tile = (size_t)256 * 2048 * 2; d.c_rt = (size_t)256 * 4096 * 2; d.c_ct = 512; break;
    case 1:
        d.A = WS_WV; d.B = WS_H; d.C = WS_VT;
        d.K = 2048; d.lda = 2048; d.ldb = 2048; d.ldc = MT; d.nM = 8; d.nN = 128; d.scale_kind = 2;
        d.a_tile = (size_t)256 * 2048 * 2; d.b_tile = (size_t)256 * 2048 * 2; d.c_rt = (size_t)256 * MT * 2; d.c_ct = 512; break;
    case 2:
        d.A = WS_MEMN; d.B = WS_WMKV; d.C = WS_KVM;
        d.K = 2048; d.lda = 2048; d.ldb = 2048; d.ldc = 4096; d.nM = 8; d.nN = 16;
        d.a_tile = (size_t)256 * 2048 * 2; d.b_tile = (size_t)256 * 2048 * 2; d.c_rt = (size_t)256 * 4096 * 2; d.c_ct = 512; break;
    case 3:
        d.A = WS_AO; d.B = WS_WOUT; d.C = WS_MIX;
        d.K = 2048; d.lda = 2048; d.ldb = 2048; d.ldc = 2048; d.nM = 128; d.nN = 8;
        d.a_tile = (size_t)256 * 2048 * 2; d.b_tile = (size_t)256 * 2048 * 2; d.c_rt = (size_t)256 * 2048 * 2; d.c_ct = 512; break;
    case 4:
        d.kind = 1; d.A = WS_KVM; d.B = WS_WMQ; d.C = WS_WKT;
        d.K = 512; d.lda = 4096; d.ldb = 2048; d.ldc = 2048; d.scale = 0.04419417382415922f * LOG2E;
        d.a_b = (size_t)256 * 4096 * 2; d.a_h = 1024; d.a_t = 0;
        d.b_b = 0; d.b_h = 1024; d.b_t = (size_t)256 * 2048 * 2;
        d.c_b = (size_t)1024 * 2048 * 2; d.c_h = (size_t)256 * 2048 * 2; d.c_t = 512; break;
    case 5:
        d.kind = 1; d.A = WS_WMO; d.B = WS_KVM + 4096; d.C = WS_VWT;
        d.K = 512; d.lda = 2048; d.ldb = 4096; d.ldc = 1024;
        d.a_b = 0; d.a_h = 1024; d.a_t = (size_t)256 * 2048 * 2;
        d.b_b = (size_t)256 * 4096 * 2; d.b_h = 1024; d.b_t = 0;
        d.c_b = (size_t)2048 * 1024 * 2; d.c_h = 512; d.c_t = (size_t)256 * 1024 * 2; break;
    case 6:
        d.A = WS_H; d.B = WS_WKT; d.C = WS_P; d.mode = 3;
        d.K = 2048; d.lda = 2048; d.ldb = 2048; d.ldc = 1024; d.nM = 128; d.nN = 4;
        d.a_tile = (size_t)256 * 2048 * 2; d.b_tile = (size_t)256 * 2048 * 2; d.b_batch = (size_t)1024 * 2048 * 2; d.c_rt = (size_t)256 * 1024 * 2; d.c_ct = 512; break;
    case 7:
        d.A = WS_P; d.B = WS_VWT; d.C = WS_MEMO;
        d.K = 1024; d.lda = 1024; d.ldb = 1024; d.ldc = 2048; d.nM = 128; d.nN = 8;
        d.a_tile = (size_t)256 * 1024 * 2; d.b_tile = (size_t)256 * 1024 * 2; d.b_batch = (size_t)2048 * 1024 * 2; d.c_rt = (size_t)256 * 2048 * 2; d.c_ct = 512; break;
    case 8:
        d.A = WS_H; d.B = WS_WGU; d.C = WS_F; d.mode = 2;
        d.K = 2048; d.lda = 2048; d.ldb = 2048; d.ldc = DFF; d.nM = 128; d.nN = 44;
        d.a_tile = (size_t)256 * 2048 * 2; d.b_tile = (size_t)256 * 2048 * 2; d.c_rt = (size_t)256 * DFF * 2; d.c_ct = 256; break;
    default:
        d.A = WS_F; d.B = WS_WDN; d.C = WS_FO;
        d.K = DFF; d.lda = DFF; d.ldb = DFF; d.ldc = 2048; d.nM = 128; d.nN = 8;
        d.a_tile = (size_t)256 * DFF * 2; d.b_tile = (size_t)256 * DFF * 2; d.c_rt = (size_t)256 * 2048 * 2; d.c_ct = 512; break;
    }
    return d;
}

template <int GI>
__device__ __forceinline__ bool sched_next(unsigned char* ws, int i, int G, int c, GUnit& u) {
    constexpr GemmDesc d = make_desc(GI);
    const int L = i * G + c;
    u.SA = 128 * d.ldc; u.SR = d.ldc; u.SB = 128; u.SX = 64; u.scale = d.scale;
    if (d.kind == 0) {
        constexpr int nwg = d.nM * d.nN;
        if (L >= nwg) return false;
        int wgid = L;
        { constexpr int q = nwg / 8, r = nwg % 8; const int xcd = wgid % 8, off = wgid / 8; wgid = (xcd < r ? xcd * (q + 1) : r * (q + 1) + (xcd - r) * q) + off; }
        constexpr int nig = 8 * d.nN; const int gid = wgid / nig, fm = gid * 8, gsz = (d.nM - fm) < 8 ? (d.nM - fm) : 8;
        const int pm = fm + ((wgid % nig) % gsz), pn = (wgid % nig) / gsz;
        u.A = (const char*)ws + d.A + (size_t)pm * d.a_tile;
        u.B = (const char*)ws + d.B + (size_t)(pm >> 4) * d.b_batch + (size_t)pn * d.b_tile;
        u.C = (char*)ws + d.C + (size_t)pm * d.c_rt + (size_t)pn * d.c_ct;
        if (d.scale_kind == 1) {
            u.scale = (pn < 4) ? 0.125f * LOG2E : ((pn >= 8 && pn < 12) ? 0.08838834764831845f * LOG2E : 1.0f);
            if (pn >= 4 && pn < 8) {
                u.C = (char*)ws + WS_KD + ((size_t)(4 * (pn - 4)) * MT + (size_t)pm * 256) * 64 * 2;
                u.SA = 128 * 64; u.SR = 64; u.SB = 2 * MT * 64; u.SX = MT * 64;
            } else if (pn >= 12) {
                u.C = (char*)ws + WS_KS + ((size_t)(2 * (pn - 12)) * MT + (size_t)pm * 256) * 128 * 2;
                u.SA = 128 * 128; u.SR = 128; u.SB = MT * 128; u.SX = 64;
            }
        } else if (d.scale_kind == 2) {
            u.C = (char*)ws + WS_VT + ((size_t)(2 * pm) * 512 + (size_t)(4 * pn)) * 8192 * 2;
            u.SA = 512 * 8192; u.SR = 64; u.SB = 2 * 8192; u.SX = 8192;
        }
        return true;
    } else {
        if (L >= 256) return false;
        const int z = L >> 3, t = L & 7, b = z >> 2, h = z & 3;
        u.A = (const char*)ws + d.A + (size_t)b * d.a_b + (size_t)h * d.a_h + (size_t)t * d.a_t;
        u.B = (const char*)ws + d.B + (size_t)b * d.b_b + (size_t)h * d.b_h + (size_t)t * d.b_t;
        u.C = (char*)ws + d.C + (size_t)b * d.c_b + (size_t)h * d.c_h + (size_t)t * d.c_t;
        return true;
    }
}

template <int mode>
__device__ __forceinline__ void epilogue(f32x4 (&acc)[2][2][4][2], const GUnit& u, int wr, int wc, int fr, int fq, LAS unsigned char* lds) {
    if (mode == 0) {
        bf16_t* base = (bf16_t*)u.C; const float sc = u.scale;
#pragma unroll
        for (int ai = 0; ai < 2; ++ai)
#pragma unroll
            for (int m = 0; m < 4; ++m) {
                bf16_t* rowp = base + (size_t)ai * u.SA + (size_t)(wr * 64 + m * 16 + fr) * u.SR + (wc >> 1) * u.SX + (wc & 1) * 32 + 8 * fq;
#pragma unroll
                for (int bj = 0; bj < 2; ++bj) {
                    const f32x4 v0 = acc[ai][bj][m][0] * sc, v1 = acc[ai][bj][m][1] * sc;
                    u32x4 w; w.x = cvtpk(v0[0], v0[1]); w.y = cvtpk(v0[2], v0[3]); w.z = cvtpk(v1[0], v1[1]); w.w = cvtpk(v1[2], v1[3]);
                    *(u32x4*)(rowp + (size_t)bj * u.SB) = w;
                }
            }
    } else if (mode == 1) {
        float* base = (float*)u.C; const float sc = u.scale;
#pragma unroll
        for (int ai = 0; ai < 2; ++ai)
#pragma unroll
            for (int m = 0; m < 4; ++m) {
                float* rowp = base + (size_t)ai * u.SA + (size_t)(wr * 64 + m * 16 + fr) * u.SR + (wc >> 1) * u.SX + (wc & 1) * 32 + 8 * fq;
#pragma unroll
                for (int bj = 0; bj < 2; ++bj) {
                    *(f32x4*)(rowp + (size_t)bj * u.SB) = acc[ai][bj][m][0] * sc;
                    *(f32x4*)(rowp + (size_t)bj * u.SB + 4) = acc[ai][bj][m][1] * sc;
                }
            }
    } else if (mode == 3) {
        LAS f32x2_t* X = (LAS f32x2_t*)(lds + 131200);
#pragma unroll
        for (int ai = 0; ai < 2; ++ai)
#pragma unroll
            for (int m = 0; m < 4; ++m) {
                float mx = -1e30f;
#pragma unroll
                for (int bj = 0; bj < 2; ++bj)
#pragma unroll
                    for (int n = 0; n < 2; ++n) { const f32x4 v = acc[ai][bj][m][n]; mx = fmaxf(mx, fmaxf(fmaxf(v[0], v[1]), fmaxf(v[2], v[3]))); }
                mx = fmaxf(mx, __shfl_xor(mx, 16)); mx = fmaxf(mx, __shfl_xor(mx, 32));
                float sum = 0.f;
#pragma unroll
                for (int bj = 0; bj < 2; ++bj)
#pragma unroll
                    for (int n = 0; n < 2; ++n) { f32x4 v = acc[ai][bj][m][n]; v[0] = ex2(v[0] - mx); v[1] = ex2(v[1] - mx); v[2] = ex2(v[2] - mx); v[3] = ex2(v[3] - mx);
                        acc[ai][bj][m][n] = v; sum += (v[0] + v[1]) + (v[2] + v[3]); }
                sum += __shfl_xor(sum, 16); sum += __shfl_xor(sum, 32);
                if (fq == 0) X[(ai * HALF + wr * 64 + m * 16 + fr) * 4 + wc] = (f32x2_t){mx, sum};
            }
        asm volatile("s_waitcnt lgkmcnt(0)" ::: "memory"); __builtin_amdgcn_s_barrier(); asm volatile("" ::: "memory");
        bf16_t* base = (bf16_t*)u.C;
#pragma unroll
        for (int ai = 0; ai < 2; ++ai)
#pragma unroll
            for (int m = 0; m < 4; ++m) {
                const int row = ai * HALF + wr * 64 + m * 16 + fr;
                const f32x2_t a0 = X[row * 4 + 0], a1 = X[row * 4 + 1], a2 = X[row * 4 + 2], a3 = X[row * 4 + 3];
                const float M = fmaxf(fmaxf(a0.x, a1.x), fmaxf(a2.x, a3.x));
                const float tot = (a0.y * ex2(a0.x - M) + a1.y * ex2(a1.x - M)) + (a2.y * ex2(a2.x - M) + a3.y * ex2(a3.x - M));
                const float own = (wc == 0) ? a0.x : (wc == 1) ? a1.x : (wc == 2) ? a2.x : a3.x;
                const float f = ex2(own - M) / tot;
                bf16_t* rowp = base + (size_t)ai * u.SA + (size_t)(wr * 64 + m * 16 + fr) * u.SR + (wc >> 1) * u.SX + (wc & 1) * 32 + 8 * fq;
#pragma unroll
                for (int bj = 0; bj < 2; ++bj) {
                    const f32x4 v0 = acc[ai][bj][m][0] * f, v1 = acc[ai][bj][m][1] * f;
                    u32x4 w; w.x = cvtpk(v0[0], v0[1]); w.y = cvtpk(v0[2], v0[3]); w.z = cvtpk(v1[0], v1[1]); w.w = cvtpk(v1[2], v1[3]);
                    *(u32x4*)(rowp + (size_t)bj * u.SB) = w;
                }
            }
    } else {
        bf16_t* base = (bf16_t*)u.C;
#pragma unroll
        for (int ai = 0; ai < 2; ++ai)
#pragma unroll
            for (int m = 0; m < 4; ++m) {
                bf16_t* rowp = base + (size_t)ai * u.SA + (size_t)(wr * 64 + m * 16 + fr) * u.SR + (wc >> 1) * u.SX + (wc & 1) * 32 + 8 * fq;
                float y[8];
#pragma unroll
                for (int n = 0; n < 2; ++n)
#pragma unroll
                    for (int j = 0; j < 4; ++j) {
                        const float g = acc[ai][0][m][n][j], up = acc[ai][1][m][n][j];
                        y[n * 4 + j] = g * __builtin_amdgcn_rcpf(1.0f + ex2(-g * LOG2E)) * up;
                    }
                u32x4 w; w.x = cvtpk(y[0], y[1]); w.y = cvtpk(y[2], y[3]); w.z = cvtpk(y[4], y[5]); w.w = cvtpk(y[6], y[7]);
                *(u32x4*)rowp = w;
            }
    }
}

template <int GI>
__device__ __forceinline__ void gemm_phase(LAS unsigned char* lds, unsigned char* ws, int G, int cblk) {
    constexpr GemmDesc g = make_desc(GI);
    int tid_ = threadIdx.x; asm volatile("" : "+v"(tid_));
    const int tid = tid_, wid = __builtin_amdgcn_readfirstlane(tid >> 6), lane = tid & 63, wr = wid >> 2, wc = wid & 3, fr = lane & 15, fq = lane >> 4;
    constexpr int K = g.K, nt = K / BK, lda = g.lda, ldb = g.ldb;
    unsigned voffA[2], voffB[2];
#pragma unroll
    for (int i = 0; i < 2; ++i) { int R, C; stage_rc(tid * 16 + i * 8192, R, C); const int Rb = (R & ~31) + perm32(R & 31);
        voffA[i] = (unsigned)(R * lda + C) * 2u; voffB[i] = (unsigned)(Rb * ldb + C) * 2u; }
    const size_t kstep = (size_t)(BK * 2);
    const size_t hstepA = (size_t)HALF * lda * 2, hstepB = (size_t)HALF * ldb * 2;
    const unsigned ldsw = (unsigned)wid * 1024u;
    const int aoff = lds_byte(wr * 64 + fr, fq * 8), boff = lds_byte(wc * 32 + fr, fq * 8);
#define PG8_SA(b, h) (((b) * 2 + (h)) * HTB)
#define PG8_SB(b, h) ((4 + (b) * 2 + (h)) * HTB)
#define PG8_STAGE(bufoff, gbase, voff) do { _Pragma("unroll") for (int _i = 0; _i < 2; ++_i) \
        __builtin_amdgcn_global_load_lds((const unsigned*)((const char*)(gbase) + (voff)[_i]), (LAS unsigned*)(lds + (bufoff) + ldsw + _i * 8192), 16, 0, 0); } while (0)
#define PG8_LDA(dst, b, h) do { _Pragma("unroll") for (int m = 0; m < 4; ++m) _Pragma("unroll") for (int k = 0; k < 2; ++k) dst[m][k] = *(const LAS bf16x8*)(lds + PG8_SA(b, h) + aoff + m * 2048 + k * 1024); } while (0)
#define PG8_LDB(dst, b, h) do { _Pragma("unroll") for (int n = 0; n < 2; ++n) _Pragma("unroll") for (int k = 0; k < 2; ++k) dst[n][k] = *(const LAS bf16x8*)(lds + PG8_SB(b, h) + boff + n * 2048 + k * 1024); } while (0)
#define PG8_MMA(ai, bj, At, Bt) do { __builtin_amdgcn_s_setprio(1); _Pragma("unroll") for (int m = 0; m < 4; ++m) _Pragma("unroll") for (int n = 0; n < 2; ++n) _Pragma("unroll") for (int k = 0; k < 2; ++k) \
        acc[ai][bj][m][n] = __builtin_amdgcn_mfma_f32_16x16x32_bf16(Bt[n][k], At[m][k], acc[ai][bj][m][n], 0, 0, 0); __builtin_amdgcn_s_setprio(0); } while (0)
#define PG8_WAIT_V(n) asm volatile("s_waitcnt vmcnt(" #n ")" ::: "memory")
#define PG8_WAIT_L(n) asm volatile("s_waitcnt lgkmcnt(" #n ")" ::: "memory")
#define PG8_BAR __builtin_amdgcn_s_barrier()
#define PG8_SCHED __builtin_amdgcn_sched_barrier(0)
    GUnit cur, nxt; int ui = 0;
    if (!sched_next<GI>(ws, 0, G, cblk, cur)) return;
    f32x4 acc[2][2][4][2];
#pragma unroll
    for (int a = 0; a < 2; ++a)
#pragma unroll
        for (int b = 0; b < 2; ++b)
#pragma unroll
            for (int m = 0; m < 4; ++m)
#pragma unroll
                for (int n = 0; n < 2; ++n) acc[a][b][m][n] = (f32x4){0.f, 0.f, 0.f, 0.f};
    bf16x8 At[4][2], B0[2][2], B1[2][2];
    const char* cA = cur.A; const char* cB = cur.B;
    PG8_STAGE(PG8_SB(0, 0), cB, voffB); PG8_STAGE(PG8_SB(0, 1), cB + hstepB, voffB); PG8_STAGE(PG8_SA(0, 0), cA, voffA); PG8_STAGE(PG8_SA(0, 1), cA + hstepA, voffA);
    if (wr == 1) PG8_BAR;
    PG8_WAIT_V(2); PG8_BAR;
    PG8_STAGE(PG8_SB(1, 0), cB + kstep, voffB); PG8_STAGE(PG8_SA(1, 0), cA + kstep, voffA); PG8_STAGE(PG8_SB(1, 1), cB + hstepB + kstep, voffB);
    PG8_WAIT_V(6); PG8_BAR;
    for (;;) {
        const bool has_next = sched_next<GI>(ws, ui + 1, G, cblk, nxt);
        const char* nA = has_next ? nxt.A : cA; const char* nB = has_next ? nxt.B : cB;
        for (int t = 0; t < nt; t += 2) {
            const bool last = (t == nt - 2);
            const char* a1 = cA + (size_t)(t + 1) * kstep;
            const char* a2 = last ? nA : cA + (size_t)(t + 2) * kstep; const char* b2 = last ? nB : cB + (size_t)(t + 2) * kstep;
            const char* a3 = a2 + kstep; const char* b3 = b2 + kstep;
            PG8_LDB(B0, 0, 0); PG8_LDB(B1, 0, 1); PG8_SCHED; PG8_LDA(At, 0, 0); PG8_STAGE(PG8_SA(1, 1), a1 + hstepA, voffA);
            PG8_WAIT_V(8); PG8_WAIT_L(0); PG8_BAR; PG8_MMA(0, 0, At, B0); PG8_MMA(0, 1, At, B1); PG8_BAR; PG8_SCHED;
            PG8_LDA(At, 0, 1); PG8_STAGE(PG8_SB(0, 0), b2, voffB); PG8_STAGE(PG8_SB(0, 1), b2 + hstepB, voffB); PG8_STAGE(PG8_SA(0, 0), a2, voffA);
            PG8_WAIT_V(8); PG8_WAIT_L(0); PG8_BAR; PG8_MMA(1, 0, At, B0); PG8_MMA(1, 1, At, B1); PG8_BAR; PG8_SCHED;
            PG8_LDB(B0, 1, 0); PG8_LDB(B1, 1, 1); PG8_SCHED; PG8_LDA(At, 1, 0); PG8_STAGE(PG8_SA(0, 1), a2 + hstepA, voffA);
            PG8_WAIT_V(8); PG8_WAIT_L(0); PG8_BAR; PG8_MMA(0, 0, At, B0); PG8_MMA(0, 1, At, B1); PG8_BAR; PG8_SCHED;
            PG8_LDA(At, 1, 1); PG8_STAGE(PG8_SB(1, 0), b3, voffB); PG8_STAGE(PG8_SB(1, 1), b3 + hstepB, voffB); PG8_STAGE(PG8_SA(1, 0), a3, voffA);
            PG8_WAIT_V(8); PG8_WAIT_L(0); PG8_BAR; PG8_MMA(1, 0, At, B0); PG8_MMA(1, 1, At, B1); PG8_BAR; PG8_SCHED;
        }
        if (wr == 0) PG8_BAR;
        epilogue<g.mode>(acc, cur, wr, wc, fr, fq, lds);
        if (!has_next) break;
#pragma unroll
        for (int a = 0; a < 2; ++a)
#pragma unroll
            for (int b = 0; b < 2; ++b)
#pragma unroll
                for (int m = 0; m < 4; ++m)
#pragma unroll
                    for (int n = 0; n < 2; ++n) acc[a][b][m][n] = (f32x4){0.f, 0.f, 0.f, 0.f};
        cur = nxt; cA = nA; cB = nB; ++ui;
        if (wr == 1) PG8_BAR;
    }
    PG8_WAIT_V(0);
    PG8_BAR;
#undef PG8_SA
#undef PG8_SB
#undef PG8_STAGE
#undef PG8_LDA
#undef PG8_LDB
#undef PG8_MMA
#undef PG8_WAIT_V
#undef PG8_WAIT_L
#undef PG8_BAR
#undef PG8_SCHED
}
}

#define XB_TMO      128
#define XB_XCNT(j)  (256  + 64 * (j))
#define XB_XSUB(j)  (1280 + 64 * (j))
#define XB_XGEN(j)  (2304 + 64 * (j))
#define XB_TOP      3328
#define XB_TOPGEN   3392
#define XCD_BAR_WORDS 3456
#define XB_SPIN_CAP (1u << 18)

__device__ __forceinline__ unsigned xb_ld(unsigned* p)              { return __hip_atomic_load(p, __ATOMIC_RELAXED, __HIP_MEMORY_SCOPE_AGENT); }
__device__ __forceinline__ unsigned xb_add(unsigned* p, unsigned v) { return __hip_atomic_fetch_add(p, v, __ATOMIC_RELAXED, __HIP_MEMORY_SCOPE_AGENT); }
__device__ __forceinline__ unsigned xb_xcc_id() { return (unsigned)__builtin_amdgcn_s_getreg((3 << 11) | 20) & 0xFu; }
#define XB_SPIN(cond, bar) do { unsigned _sp = 0; while (cond) { __builtin_amdgcn_s_sleep(1); \
    if ((++_sp & 255u) == 0u) { if (xb_ld(&(bar)[XB_TMO])) break; if (_sp > XB_SPIN_CAP) { atomicAdd(&(bar)[XB_TMO], 1u); break; } } } } while (0)

struct XcdBarrier {
    unsigned* bar; unsigned x;
    volatile LAS unsigned* st;
};

__device__ __forceinline__ XcdBarrier xcd_barrier_post(unsigned* bar, volatile LAS unsigned* st) {
    XcdBarrier b; b.bar = bar; b.x = xb_xcc_id(); b.st = st;
    if (threadIdx.x == 0) (void)xb_add(&bar[XB_XCNT(b.x)], 1u);
    return b;
}
__device__ __forceinline__ void xcd_barrier_complete(unsigned* bar, unsigned x, unsigned& nloc, unsigned& nx) {
    const unsigned G = gridDim.x * gridDim.y * gridDim.z;
    unsigned sum, cnt, mine, sp = 0u;
    for (;;) {
        sum = 0u; cnt = 0u; mine = 0u;
#pragma unroll
        for (unsigned j = 0; j < 16; ++j) { const unsigned c = xb_ld(&bar[XB_XCNT(j)]); sum += c; cnt += (c > 0u) ? 1u : 0u; mine = (j == x) ? c : mine; }
        if (sum == G) break;
        __builtin_amdgcn_s_sleep(1);
        if ((++sp & 255u) == 0u) { if (xb_ld(&bar[XB_TMO])) break; if (sp > XB_SPIN_CAP) { atomicAdd(&bar[XB_TMO], 1u); break; } }
    }
    nloc = mine > 0u ? mine : 1u; nx = cnt > 0u ? cnt : 1u;
}

__device__ __forceinline__ void xcd_barrier(const XcdBarrier& b) {
    asm volatile("s_waitcnt vmcnt(0)" ::: "memory");
    __syncthreads();
    if (threadIdx.x == 0) {
        unsigned* bar = b.bar;
        __builtin_amdgcn_s_waitcnt(0);
        unsigned nloc = b.st[0], nx = b.st[1];
        if (nloc == 0u) { xcd_barrier_complete(bar, b.x, nloc, nx); b.st[0] = nloc; b.st[1] = nx; }
        const unsigned old = xb_add(&bar[XB_XSUB(b.x)], 1u);
        const unsigned gen = old / nloc;
        if (old + 1u == (gen + 1u) * nloc) {
            __builtin_amdgcn_fence(__ATOMIC_RELEASE, "agent");
            asm volatile("s_waitcnt vmcnt(0)" ::: "memory");
            const unsigned og = xb_add(&bar[XB_TOP], 1u);
            const unsigned tg = og / nx;
            if (og + 1u == (tg + 1u) * nx) xb_add(&bar[XB_TOPGEN], 1u);
            else XB_SPIN(xb_ld(&bar[XB_TOPGEN]) == tg, bar);
            __builtin_amdgcn_fence(__ATOMIC_ACQUIRE, "agent");
            xb_add(&bar[XB_XGEN(b.x)], 1u);
            asm volatile("s_waitcnt vmcnt(0)" ::: "memory");
        } else {
            XB_SPIN(xb_ld(&bar[XB_XGEN(b.x)]) == gen, bar);
            __builtin_amdgcn_fence(__ATOMIC_ACQUIRE, "agent");
            asm volatile("s_waitcnt vmcnt(0)" ::: "memory");
        }
    }
    __syncthreads();
}

__device__ __forceinline__ void tr_item(const float* W, int N, int K, int k0, int n0, bf16_t* dst, LAS float* scr, int lane) {
#pragma unroll 8
    for (int i = 0; i < 32; ++i) { const int kk = 2 * i + (lane >> 5); scr[kk * 33 + (lane & 31)] = W[(size_t)(k0 + kk) * N + n0 + (lane & 31)]; }
    asm volatile("s_waitcnt lgkmcnt(0)" ::: "memory");
    const int c = lane & 7;
#pragma unroll
    for (int j = 0; j < 4; ++j) { const int n = (lane >> 3) + 8 * j; const LAS float* s = scr + (8 * c) * 33 + n;
        u32x4 o; o.x = cvtpk(s[0 * 33], s[1 * 33]); o.y = cvtpk(s[2 * 33], s[3 * 33]); o.z = cvtpk(s[4 * 33], s[5 * 33]); o.w = cvtpk(s[6 * 33], s[7 * 33]);
        *(u32x4*)(dst + (size_t)n * K + k0 + 8 * c) = o; }
    asm volatile("s_waitcnt lgkmcnt(0)" ::: "memory");
}

__device__ __forceinline__ void rms_row_bf16(const float* xrow, const float* g, bf16_t* orow, int lane) {
    const f32x4* xr = (const f32x4*)xrow + lane;
    f32x4 v[8]; float s = 0.f;
#pragma unroll
    for (int j = 0; j < 8; ++j) { v[j] = NTL(xr[64 * j]); s += (v[j].x * v[j].x + v[j].y * v[j].y) + (v[j].z * v[j].z + v[j].w * v[j].w); }
    const float r = 1.0f / sqrtf(wave_sum(s) * (1.0f / DM) + EPS);
    const f32x4* gr = (const f32x4*)g + lane;
    u32x2* o8 = (u32x2*)orow + lane;
#pragma unroll
    for (int j = 0; j < 8; ++j) { const f32x4 gv = gr[64 * j]; u32x2 w; w.x = cvtpk(v[j].x * r * gv.x, v[j].y * r * gv.y); w.y = cvtpk(v[j].z * r * gv.z, v[j].w * r * gv.w); o8[64 * j] = w; }
}

template <int PART>
__device__ __forceinline__ void prologue(const Params& p, LAS unsigned char* lds, int G, int blk) {
    const int tid = threadIdx.x, lane = tid & 63, wave = __builtin_amdgcn_readfirstlane(tid >> 6);
    LAS float* scr = (LAS float*)(lds + wave * 16384);
    const int gw = (PART == 0 ? blk : blk - G / 2) * 8 + wave, NGW = (PART == 0 ? G : G - G / 2) * 8;
    unsigned char* ws = p.ws;
    bf16_t* Wqk = (bf16_t*)(ws + WS_WQK); bf16_t* Wv = (bf16_t*)(ws + WS_WV); bf16_t* Wout = (bf16_t*)(ws + WS_WOUT);
    bf16_t* Wmkv = (bf16_t*)(ws + WS_WMKV); bf16_t* Wmo = (bf16_t*)(ws + WS_WMO); bf16_t* Wgu = (bf16_t*)(ws + WS_WGU); bf16_t* Wdn = (bf16_t*)(ws + WS_WDN);
    constexpr int I0 = 32 * 192, I1 = 32 * 64, I2 = 32 * 128, I3 = 32 * 64, I4 = 32 * 352, I5 = 88 * 64;
    constexpr int NA = I0 + I1 + I2 + I3, NIT = NA + I4 + I5;
    for (int it = (PART == 0 ? 0 : NA) + gw; it < (PART == 0 ? NA : NIT); it += NGW) {
        int r = it;
        if (r < I0) { const int kb = r / 192, nb = r % 192, n0 = nb * 32; bf16_t* dst;
            if (n0 < 2048) dst = Wqk + (size_t)n0 * 2048;
            else if (n0 < 3072) dst = Wv + (size_t)(n0 - 2048) * 2048;
            else if (n0 < 5120) dst = Wqk + (size_t)(2048 + n0 - 3072) * 2048;
            else dst = Wv + (size_t)(1024 + n0 - 5120) * 2048;
            tr_item(p.w_in, 6144, 2048, kb * 64, n0, dst, scr, lane); continue; }
        r -= I0;
        if (r < I1) { const int kb = r / 64, nb = r % 64; tr_item(p.w_out, 2048, 2048, kb * 64, nb * 32, Wout + (size_t)(nb * 32) * 2048, scr, lane); continue; }
        r -= I1;
        if (r < I2) { const int kb = r / 128, nb = r % 128; tr_item(p.w_mkv, 4096, 2048, kb * 64, nb * 32, Wmkv + (size_t)(nb * 32) * 2048, scr, lane); continue; }
        r -= I2;
        if (r < I3) { const int kb = r / 64, nb = r % 64; tr_item(p.w_mo, 2048, 2048, kb * 64, nb * 32, Wmo + (size_t)(nb * 32) * 2048, scr, lane); continue; }
        r -= I3;
        if (r < I4) { const int kb = r / 352, nb = r % 352, n0 = nb * 32; int drow;
            if (n0 < DFF) drow = 256 * (n0 / 128) + (n0 % 128); else { const int c2 = n0 - DFF; drow = 256 * (c2 / 128) + 128 + (c2 % 128); }
            tr_item(p.w_gu, 2 * DFF, 2048, kb * 64, n0, Wgu + (size_t)drow * 2048, scr, lane); continue; }
        r -= I4;
        { const int kb = r / 64, nb = r % 64; tr_item(p.w_down, 2048, DFF, kb * 64, nb * 32, Wdn + (size_t)(nb * 32) * DFF, scr, lane); }
    }
    if (PART == 1) return;
    { bf16_t* Wmq = (bf16_t*)(ws + WS_WMQ); const int gt = blk * 512 + tid, NGT = G * 512;
      for (int i = gt; i < 2048 * 2048 / 4; i += NGT) { const f32x4 v = ((const f32x4*)p.w_mq)[i]; u32x2 w; w.x = cvtpk(v.x, v.y); w.y = cvtpk(v.z, v.w); ((u32x2*)Wmq)[i] = w; } }
    bf16_t* H = (bf16_t*)(ws + WS_H); bf16_t* memn = (bf16_t*)(ws + WS_MEMN);
    for (int m = gw; m < MT; m += NGW) rms_row_bf16(p.x + (size_t)m * DM, p.g_mix_pre, H + (size_t)m * DM, lane);
    for (int m = gw; m < NB * 256; m += NGW) rms_row_bf16(p.mem + (size_t)m * DM, p.g_mem_kv, memn + (size_t)m * DM, lane);
}

template <bool HAS_H, bool XIN_BF, bool XOUT_BF>
__device__ __forceinline__ void row_pass(const bf16_t* y, const void* xin, void* xout, const float* g_post, const float* g_pre, bf16_t* hout, int G, int blk) {
    const int tid = threadIdx.x, lane = tid & 63, wave = tid >> 6;
    const int gw = blk * 8 + wave, NGW = G * 8;
    for (int row = gw; row < MT; row += NGW) {
        const u32x2* yr = (const u32x2*)(y + (size_t)row * DM) + lane;
        const f32x4* xr = (const f32x4*)((const float*)xin + (size_t)row * DM) + lane;
        const u32x2* xrb = (const u32x2*)((const bf16_t*)xin + (size_t)row * DM) + lane;
        f32x4 yv[8], xv[8]; float s = 0.f;
#pragma unroll
        for (int j = 0; j < 8; ++j) { const u32x2 w = NTL(yr[64 * j]); yv[j] = (f32x4){bf_lo(w.x), bf_hi(w.x), bf_lo(w.y), bf_hi(w.y)};
            if (XIN_BF) { const u32x2 xw = NTL(xrb[64 * j]); xv[j] = (f32x4){bf_lo(xw.x), bf_hi(xw.x), bf_lo(xw.y), bf_hi(xw.y)}; } else xv[j] = NTL(xr[64 * j]);
            s += (yv[j].x * yv[j].x + yv[j].y * yv[j].y) + (yv[j].z * yv[j].z + yv[j].w * yv[j].w); }
        const float r = 1.0f / sqrtf(wave_sum(s) * (1.0f / DM) + EPS);
        const f32x4* gp = (const f32x4*)g_post + lane;
        f32x4* xo = (f32x4*)((float*)xout + (size_t)row * DM) + lane;
        u32x2* xob = (u32x2*)((bf16_t*)xout + (size_t)row * DM) + lane;
        float s1 = 0.f;
#pragma unroll
        for (int j = 0; j < 8; ++j) { const f32x4 gv = gp[64 * j]; xv[j] = xv[j] + yv[j] * r * gv;
            if (XOUT_BF) { u32x2 w; w.x = cvtpk(xv[j].x, xv[j].y); w.y = cvtpk(xv[j].z, xv[j].w); NTS(w, xob[64 * j]); } else NTS(xv[j], xo[64 * j]);
            s1 += (xv[j].x * xv[j].x + xv[j].y * xv[j].y) + (xv[j].z * xv[j].z + xv[j].w * xv[j].w); }
        if (HAS_H) {
            const float r1 = 1.0f / sqrtf(wave_sum(s1) * (1.0f / DM) + EPS);
            const f32x4* gq = (const f32x4*)g_pre + lane;
            u32x2* ho = (u32x2*)(hout + (size_t)row * DM) + lane;
#pragma unroll
            for (int j = 0; j < 8; ++j) { const f32x4 gv = gq[64 * j]; u32x2 w; w.x = cvtpk(xv[j].x * r1 * gv.x, xv[j].y * r1 * gv.y); w.y = cvtpk(xv[j].z * r1 * gv.z, xv[j].w * r1 * gv.w); ho[64 * j] = w; }
        }
    }
}

__device__ __forceinline__ void softmax_pass(const float* S, bf16_t* P, int G, int blk) {
    const int tid = threadIdx.x, lane = tid & 63, wave = tid >> 6;
    const int gw = blk * 8 + wave, NGW = G * 8;
    for (int row = gw; row < MT; row += NGW) {
        const f32x4* sr = (const f32x4*)(S + (size_t)row * 1024) + lane;
        u32x2* pr = (u32x2*)(P + (size_t)row * 1024) + lane;
        f32x4 v[4];
#pragma unroll
        for (int h = 0; h < 4; ++h) v[h] = sr[64 * h];
#pragma unroll
        for (int h = 0; h < 4; ++h) {
            const float mx = wave_max(fmaxf(fmaxf(v[h].x, v[h].y), fmaxf(v[h].z, v[h].w)));
            f32x4 e; e.x = ex2(v[h].x - mx); e.y = ex2(v[h].y - mx); e.z = ex2(v[h].z - mx); e.w = ex2(v[h].w - mx);
            const float inv = 1.0f / wave_sum((e.x + e.y) + (e.z + e.w));
            u32x2 w; w.x = cvtpk(e.x * inv, e.y * inv); w.y = cvtpk(e.z * inv, e.w * inv); pr[64 * h] = w;
        }
    }
}

#ifndef PROBE_DIFF_REPS
#define PROBE_DIFF_REPS 1
#endif
#ifndef PROBE_SB_REPS
#define PROBE_SB_REPS 1
#endif
constexpr int A_KBUF = 16384, A_VBUF = 16384, A_KOFF = 0, A_VOFF = 2 * A_KBUF, A_TAB = A_VOFF + 2 * A_VBUF, A_FLAG = A_TAB + 1024;
#define MFMA32(a, b, c) __builtin_amdgcn_mfma_f32_32x32x16_bf16((a), (b), (c), 0, 0, 0)
#define SCHEDB() __builtin_amdgcn_sched_barrier(0)
__device__ __forceinline__ int crow(int r, int h) { return (r & 3) + 8 * (r >> 2) + 4 * h; }

template <int KD>
__device__ __forceinline__ void tile_dma(const bf16_t* Kg, const bf16_t* Vg, LAS unsigned char* kb, LAS unsigned char* vb, int wid, int lane) {
    if (KD == 128) {
#pragma unroll
        for (int i = 0; i < 2; ++i) {
            const int kc = wid * 2 + i, rho = 4 * kc + (lane >> 4), x = lane & 15, i5 = rho & 31;
            const int key = (rho & 32) + 16 * ((i5 >> 2) & 1) + 8 * (i5 >> 4) + 4 * ((i5 >> 3) & 1) + (i5 & 3);
            const bf16_t* src = Kg + (size_t)key * KD + ((x ^ (rho & 15)) * 8);
            __builtin_amdgcn_global_load_lds((const unsigned*)src, (LAS unsigned*)(kb + kc * 1024), 16, 0, 0);
        }
    } else {
        const int kc = wid, rho = 8 * kc + (lane >> 3), x = lane & 7, i5 = rho & 31;
        const int key = (rho & 32) + 16 * ((i5 >> 2) & 1) + 8 * (i5 >> 4) + 4 * ((i5 >> 3) & 1) + (i5 & 3);
        const bf16_t* src = Kg + (size_t)key * KD + ((x ^ ((rho >> 1) & 7)) * 8);
        __builtin_amdgcn_global_load_lds((const unsigned*)src, (LAS unsigned*)(kb + kc * 1024), 16, 0, 0);
    }
#pragma unroll
    for (int i = 0; i < 2; ++i) {
        const int vc = wid * 2 + i, rho = 8 * vc + (lane >> 3), x = lane & 7;
        const bf16_t* src = Vg + (size_t)rho * 64 + ((x ^ ((rho >> 1) & 7)) * 8);
        __builtin_amdgcn_global_load_lds((const unsigned*)src, (LAS unsigned*)(vb + vc * 1024), 16, 0, 0);
    }
}
__device__ __forceinline__ bf16x8 pack8(const f32x16& s, int o) {
    u32x4 w; w.x = cvtpk(s[o], s[o + 1]); w.y = cvtpk(s[o + 2], s[o + 3]); w.z = cvtpk(s[o + 4], s[o + 5]); w.w = cvtpk(s[o + 6], s[o + 7]);
    return __builtin_bit_cast(bf16x8, w);
}
__device__ __forceinline__ void pv_acc(f32x16 (&O)[4], const f32x16& s0, const f32x16& s1, const LAS unsigned char* vbase, int xv) {
#pragma unroll
    for (int g = 0; g < 4; ++g) {
        const int kbk = g >> 1, s = g & 1;
        const int co = ((4 * kbk + s) ^ xv) << 4;
        bf16x8 vf[4];
#pragma unroll
        for (int db = 0; db < 4; ++db) vf[db] = *(const LAS bf16x8*)(vbase + db * 4096 + co);
        const bf16x8 pf = pack8(kbk ? s1 : s0, 8 * s);
#pragma unroll
        for (int db = 0; db < 4; ++db) O[db] = MFMA32(pf, vf[db], O[db]);
        SCHEDB();
    }
}
template <int NKS, int ROWB>
__device__ __forceinline__ void qk_tile(f32x16& s0, f32x16& s1, const LAS unsigned char* kb, int xk, const bf16x8* qf) {
    bf16x8 a[2][2];
    { const int co = (0 ^ xk) << 4; a[0][0] = *(const LAS bf16x8*)(kb + co); a[0][1] = *(const LAS bf16x8*)(kb + 32 * ROWB + co); }
#pragma unroll
    for (int ks = 0; ks < NKS; ++ks) {
        if (ks + 1 < NKS) { const int co = ((2 * (ks + 1)) ^ xk) << 4; a[(ks + 1) & 1][0] = *(const LAS bf16x8*)(kb + co); a[(ks + 1) & 1][1] = *(const LAS bf16x8*)(kb + 32 * ROWB + co); }
        s0 = MFMA32(a[ks & 1][0], qf[ks], s0); s1 = MFMA32(a[ks & 1][1], qf[ks], s1);
        SCHEDB();
    }
}

__device__ __forceinline__ void smax_update(f32x16& s0, f32x16& s1, float& m, float& l, f32x16 (&O)[4], int hh) {
    float mx = fmaxf(s0[0], s1[0]);
#pragma unroll
    for (int r = 1; r < 16; ++r) mx = fmaxf(mx, fmaxf(s0[r], s1[r]));
    mx = fmaxf(mx, __shfl_xor(mx, 32));
    if (__any(mx > m + 8.0f)) {
        const float mn = fmaxf(m, mx);
        const float alpha = ex2(m - mn);
        l *= alpha; m = mn;
        int hl = hh; asm volatile("" : "+v"(hl));
#pragma unroll
        for (int r = 0; r < 16; ++r) { const float a = __shfl(alpha, crow(r, hl));
#pragma unroll
            for (int db = 0; db < 4; ++db) O[db][r] *= a; }
    }
    float sum = 0.f;
#pragma unroll
    for (int r = 0; r < 16; ++r) { s0[r] = ex2(s0[r] - m); s1[r] = ex2(s1[r] - m); sum += s0[r] + s1[r]; }
    l += sum;
}

#define MX3(a, b, c) __builtin_fmaxf(__builtin_fmaxf((a), (b)), (c))
__device__ __forceinline__ void diff_unit(const Params& p, LAS unsigned char* lds, int b, int h, int qb, float lam) {
    int tid_ = threadIdx.x; asm volatile("" : "+v"(tid_));
    const int tid = tid_, lane = tid & 63, wid = __builtin_amdgcn_readfirstlane(tid >> 6), c = lane & 31, hh = lane >> 5;
    const bf16_t* QK = (const bf16_t*)(p.ws + WS_QK); const bf16_t* VT = (const bf16_t*)(p.ws + WS_VT); bf16_t* AO = (bf16_t*)(p.ws + WS_AO);
    const size_t rowbase = (size_t)b * SEQ;
    const int q0 = qb * 256 + wid * 32, mylast = q0 >> 6, NT = 4 * qb + 4;
    const int xk = ((c >> 1) & 7) ^ hh, xv = ((c >> 1) & 7) ^ (2 * hh);
    LAS float* tab = (LAS float*)(lds + A_TAB);
    if (tid < 256) { const int d = tid - 64, n = d < 0 ? -d : d; int bk = (n < 8) ? n : min(15, 2 + (31 - __clz(n * n))); if (d < 0) bk += 16;
        tab[tid] = (p.rel_bias[bk * 8 + h] - p.rel_bias[15 * 8 + h]) * LOG2E; }
    const bf16_t* Vg0 = VT + ((size_t)h * 512 + (size_t)b * 64) * 8192;
    unsigned* park = (unsigned*)(p.ws + WS_PARK) + ((size_t)(blockIdx.x * 8 + wid) * 32) * 64 + lane;
    const bf16x8 ones = (bf16x8){0x3f80, 0x3f80, 0x3f80, 0x3f80, 0x3f80, 0x3f80, 0x3f80, 0x3f80};
    f32x16 O[4];
#pragma unroll
    for (int mp = 0; mp < 2; ++mp) {
        const bf16_t* Kg0 = (const bf16_t*)(p.ws + WS_KD) + ((size_t)(2 * h + mp) * MT + rowbase) * 64;
        tile_dma<64>(Kg0, Vg0, lds + A_KOFF, lds + A_VOFF, wid, lane);
        const bf16_t* qp = QK + (rowbase + q0 + c) * 4096 + h * 128 + 64 * mp + hh * 8;
        bf16x8 qf[4];
#pragma unroll
        for (int ks = 0; ks < 4; ++ks) qf[ks] = *(const bf16x8*)(qp + 16 * ks);
#pragma unroll
        for (int db = 0; db < 4; ++db) O[db] = (f32x16){};
        f32x16 L = (f32x16){};
        f32x16 negm = (f32x16){};
        float m = 0.f;
        asm volatile("s_waitcnt vmcnt(0)" ::: "memory");
        __syncthreads();
        for (int jt = 0; jt < NT; ++jt) {
            const int cur = jt & 1;
            if (jt + 1 < NT) tile_dma<64>(Kg0 + (size_t)(jt + 1) * 4096, Vg0 + (size_t)(jt + 1) * 8192, lds + A_KOFF + (cur ^ 1) * A_KBUF, lds + A_VOFF + (cur ^ 1) * A_VBUF, wid, lane);
            if (jt <= mylast) {
                const LAS unsigned char* kb = lds + A_KOFF + cur * A_KBUF + c * 128;
                const LAS unsigned char* vb = lds + A_VOFF + cur * A_VBUF + c * 128;
                f32x16 s0, s1;
                {
                    bf16x8 a[2][2];
                    { const int co = (0 ^ xk) << 4; a[0][0] = *(const LAS bf16x8*)(kb + co); a[0][1] = *(const LAS bf16x8*)(kb + 4096 + co); }
#pragma unroll
                    for (int ks = 0; ks < 4; ++ks) {
                        if (ks + 1 < 4) { const int co = ((2 * (ks + 1)) ^ xk) << 4; a[(ks + 1) & 1][0] = *(const LAS bf16x8*)(kb + co); a[(ks + 1) & 1][1] = *(const LAS bf16x8*)(kb + 4096 + co); }
                        if (ks == 0) { s0 = MFMA32(a[0][0], qf[0], negm); s1 = MFMA32(a[0][1], qf[0], negm); }
                        else { s0 = MFMA32(a[ks & 1][0], qf[ks], s0); s1 = MFMA32(a[ks & 1][1], qf[ks], s1); }
                        SCHEDB();
                    }
                }
                if ((q0 - (64 * jt + 63)) < 91) {
                    const int idx0 = (q0 + c) - (64 * jt + 16 * hh) + 64;
#pragma unroll
                    for (int r = 0; r < 16; ++r) { s0[r] += tab[min(idx0 - r, 255)]; s1[r] += tab[min(idx0 - 32 - r, 255)]; if ((r & 3) == 3) SCHEDB(); }
                }
                float mx;
                { float a0 = MX3(s0[0], s0[1], s1[0]), a1 = MX3(s0[2], s0[3], s1[1]); a0 = MX3(a0, s1[2], s1[3]);
#pragma unroll
                  for (int r = 4; r < 16; r += 4) { a0 = MX3(a0, s0[r], s0[r + 1]); a1 = MX3(a1, s0[r + 2], s0[r + 3]); a0 = MX3(a0, s1[r], s1[r + 1]); a1 = MX3(a1, s1[r + 2], s1[r + 3]); }
                  mx = fmaxf(a0, a1); }
                { auto rr = __builtin_amdgcn_permlane32_swap(__float_as_uint(mx), __float_as_uint(mx), false, false); mx = fmaxf(__uint_as_float(rr[0]), __uint_as_float(rr[1])); }
                const bool first = (jt == 0);
                if (first || __any(mx > 8.0f)) {
                    const float dl = first ? mx : fmaxf(mx, 0.f);
                    m += dl;
#pragma unroll
                    for (int r = 0; r < 16; ++r) { s0[r] -= dl; s1[r] -= dl; }
#pragma unroll
                    for (int r = 0; r < 16; ++r) negm[r] = -m;
                    if (!first) {
                        const float alpha = ex2(-dl);
                        int hl = hh; asm volatile("" : "+v"(hl));
#pragma unroll
                        for (int r = 0; r < 16; ++r) { const float a = __shfl(alpha, crow(r, hl)); L[r] *= a;
#pragma unroll
                            for (int db = 0; db < 4; ++db) O[db][r] *= a; }
                    }
                }
#pragma unroll
                for (int r = 0; r < 16; ++r) s0[r] = ex2(s0[r]);
#pragma unroll
                for (int g = 0; g < 4; ++g) {
                    const int co = ((4 * (g >> 1) + (g & 1)) ^ xv) << 4;
                    bf16x8 vf[4];
#pragma unroll
                    for (int db = 0; db < 4; ++db) vf[db] = *(const LAS bf16x8*)(vb + db * 4096 + co);
                    const bf16x8 pf = pack8((g >> 1) ? s1 : s0, 8 * (g & 1));
#pragma unroll
                    for (int db = 0; db < 4; ++db) O[db] = MFMA32(pf, vf[db], O[db]);
                    L = MFMA32(pf, ones, L);
                    if (g < 2) {
#pragma unroll
                        for (int r = 0; r < 8; ++r) s1[8 * g + r] = ex2(s1[8 * g + r]);
                    }
                    SCHEDB();
                }
            }
            asm volatile("s_waitcnt vmcnt(0)" ::: "memory");
            __syncthreads();
        }
#pragma unroll
        for (int r = 0; r < 16; ++r) { const float a = (mp == 0 ? 1.0f : lam) / L[r];
#pragma unroll
            for (int db = 0; db < 4; ++db) O[db][r] *= a; }
        if (mp == 0) {
#pragma unroll
            for (int db = 0; db < 4; ++db)
#pragma unroll
                for (int j = 0; j < 8; ++j) park[(db * 8 + j) * 64] = cvtpk(O[db][2 * j], O[db][2 * j + 1]);
        }
    }
    float gn[4];
#pragma unroll
    for (int db = 0; db < 4; ++db) gn[db] = p.diff_gain[32 * db + c] * 0.8f;
#pragma unroll
    for (int r = 0; r < 16; ++r) {
        const int qr = crow(r, hh);
        float o[4]; float ss = 0.f;
#pragma unroll
        for (int db = 0; db < 4; ++db) { const unsigned w = park[(db * 8 + (r >> 1)) * 64]; o[db] = ((r & 1) ? bf_hi(w) : bf_lo(w)) - O[db][r]; ss += o[db] * o[db]; }
#pragma unroll
        for (int off = 1; off < 32; off <<= 1) ss += __shfl_xor(ss, off);
        const float rs = 1.0f / sqrtf(ss * (1.0f / 128.0f) + EPS);
        bf16_t* op = AO + (rowbase + q0 + qr) * DM + h * 128 + c;
#pragma unroll
        for (int db = 0; db < 4; ++db) op[32 * db] = (bf16_t)(cvtpk(o[db] * rs * gn[db], 0.f) & 0xffffu);
    }
}
#undef MX3

__device__ __forceinline__ void sb_unit(const Params& p, LAS unsigned char* lds, int b, int h, int qb) {
    int tid_ = threadIdx.x; asm volatile("" : "+v"(tid_));
    const int tid = tid_, lane = tid & 63, wid = __builtin_amdgcn_readfirstlane(tid >> 6), c = lane & 31, hh = lane >> 5;
    const bf16_t* QK = (const bf16_t*)(p.ws + WS_QK); const bf16_t* VT = (const bf16_t*)(p.ws + WS_VT); bf16_t* AO = (bf16_t*)(p.ws + WS_AO);
    const size_t rowbase = (size_t)b * SEQ;
    const int q0 = qb * 256 + wid * 32, mylast = q0 >> 6, T0 = 4 * qb + 3;
    const int xk = (c & 15) ^ hh, xv = ((c >> 1) & 7) ^ (2 * hh);
    LAS unsigned* flag = (LAS unsigned*)(lds + A_FLAG);
    const bf16_t* Kg0 = (const bf16_t*)(p.ws + WS_KS) + ((size_t)h * MT + rowbase) * 128;
    const bf16_t* Vg0 = VT + ((size_t)(8 + h) * 512 + (size_t)b * 64) * 8192;
    tile_dma<128>(Kg0 + (size_t)T0 * 8192, Vg0 + (size_t)T0 * 8192, lds + A_KOFF, lds + A_VOFF, wid, lane);
    const bf16_t* qp = QK + (rowbase + q0 + c) * 4096 + 2048 + h * 128 + hh * 8;
    bf16x8 qf[8];
#pragma unroll
    for (int ks = 0; ks < 8; ++ks) qf[ks] = *(const bf16x8*)(qp + 16 * ks);
    f32x16 O[4];
#pragma unroll
    for (int db = 0; db < 4; ++db) O[db] = (f32x16){};
    float carry = 0.f; bool done = false;
    asm volatile("s_waitcnt vmcnt(0)" ::: "memory");
    __syncthreads();
    for (int jt = T0; jt >= 0; --jt) {
        const int cur = (T0 - jt) & 1;
        if (jt > 0) tile_dma<128>(Kg0 + (size_t)(jt - 1) * 8192, Vg0 + (size_t)(jt - 1) * 8192, lds + A_KOFF + (cur ^ 1) * A_KBUF, lds + A_VOFF + (cur ^ 1) * A_VBUF, wid, lane);
        if (jt <= mylast && !done) {
            const LAS unsigned char* kb = lds + A_KOFF + cur * A_KBUF + c * 256;
            const LAS unsigned char* vb = lds + A_VOFF + cur * A_VBUF + c * 128;
            f32x16 s0 = (f32x16){}, s1 = (f32x16){};
            qk_tile<8, 256>(s0, s1, kb, xk, qf);
            const bool diag = (jt == mylast);
            const int lim = (q0 + c) - (64 * jt + 16 * hh);
            float run = 0.f;
#pragma unroll
            for (int r = 15; r >= 0; --r) {
                const float z = s1[r]; const float sp = fmaxf(z, 0.f) + lg2(1.0f + ex2(-fabsf(z)));
                float lk = -sp, lb = z - sp;
                if (diag && !(r + 32 < lim)) { lk = 0.f; lb = -1e30f; }
                s1[r] = lb + run; run += lk;
            }
            const float T1 = run; run = 0.f;
#pragma unroll
            for (int r = 15; r >= 0; --r) {
                const float z = s0[r]; const float sp = fmaxf(z, 0.f) + lg2(1.0f + ex2(-fabsf(z)));
                float lk = -sp, lb = z - sp;
                if (diag && !(r < lim)) { lk = 0.f; lb = -1e30f; }
                s0[r] = lb + run; run += lk;
            }
            const float T0s = run;
            const float T1p = __shfl_xor(T1, 32), T0p = __shfl_xor(T0s, 32);
            const float off1 = carry + (hh ? 0.f : T1p);
            const float off0 = carry + T1 + T1p + (hh ? 0.f : T0p);
#pragma unroll
            for (int r = 0; r < 16; ++r) { s1[r] = ex2(s1[r] + off1); s0[r] = ex2(s0[r] + off0); }
            carry += (T1 + T1p) + (T0s + T0p);
            pv_acc(O, s0, s1, vb, xv);
            done = __all(carry < -60.0f);
        }
        if (lane == 0) flag[cur * 8 + wid] = done ? 1u : 0u;
        asm volatile("s_waitcnt vmcnt(0)" ::: "memory");
        __syncthreads();
        const u32x4 f0 = *(const LAS u32x4*)(flag + cur * 8), f1 = *(const LAS u32x4*)(flag + cur * 8 + 4);
        if ((f0.x & f0.y & f0.z & f0.w & f1.x & f1.y & f1.z & f1.w) != 0u) break;
    }
    float gn[4];
#pragma unroll
    for (int db = 0; db < 4; ++db) gn[db] = p.sb_gain[32 * db + c];
#pragma unroll
    for (int r = 0; r < 16; ++r) {
        const int qr = crow(r, hh);
        float ss = 0.f;
#pragma unroll
        for (int db = 0; db < 4; ++db) ss += O[db][r] * O[db][r];
#pragma unroll
        for (int off = 1; off < 32; off <<= 1) ss += __shfl_xor(ss, off);
        const float rs = 1.0f / sqrtf(ss * (1.0f / 128.0f) + EPS);
        bf16_t* op = AO + (rowbase + q0 + qr) * DM + 1024 + h * 128 + c;
#pragma unroll
        for (int db = 0; db < 4; ++db) op[32 * db] = (bf16_t)(cvtpk(O[db][r] * rs * gn[db], 0.f) & 0xffffu);
    }
    asm volatile("s_waitcnt vmcnt(0)" ::: "memory");
    __syncthreads();
}

__device__ __forceinline__ void attention_phase(const Params& p, LAS unsigned char* lds, int G, int blk) {
    float s1 = 0.f, s2 = 0.f;
    for (int i = 0; i < 64; ++i) { s1 += p.lq1[i] * p.lk1[i]; s2 += p.lq2[i] * p.lk2[i]; }
    const float lam = expf(s1) - expf(s2) + 0.2f;
    const int v = (G % 8 == 0) ? (blk % 8) * (G / 8) + blk / 8 : blk;
    for (int rep = 0; rep < PROBE_DIFF_REPS; ++rep)
    for (int u = v; u < 1024; u += G) {
        const int bh = (u & 255) >> 2, s = u & 3, i = u >> 8;
        const int qb = (i == 0) ? s : (i == 1) ? 7 - s : (i == 2) ? 8 + s : 15 - s;
#ifndef NO_DIFF
        diff_unit(p, lds, bh >> 3, bh & 7, qb, lam);
#endif
    }
    for (int rep = 0; rep < PROBE_SB_REPS; ++rep)
    for (int u = v; u < 1024; u += G) {
        const int bh = (u & 255) >> 2, s = u & 3, i = u >> 8;
        const int qb = (i == 0) ? s : (i == 1) ? 7 - s : (i == 2) ? 8 + s : 15 - s;
#ifndef NO_SB
        sb_unit(p, lds, bh >> 3, bh & 7, qb);
#endif
    }
}

constexpr int LDS_BYTES = 143360;

__global__ void __launch_bounds__(512) fwd_megakernel(Params p) {
    extern __shared__ __attribute__((aligned(16))) unsigned char lds_raw[];
    LAS unsigned char* lds = (LAS unsigned char*)lds_raw;
    cg::grid_group grid = cg::this_grid();
    const int G = gridDim.x, blk = blockIdx.x;
    unsigned char* ws = p.ws;

#ifdef ONLY_GEMM
#define GEMM(gi) do { if (gi == ONLY_GEMM) pg8::gemm_phase<gi>(lds, ws, G, blk); } while (0)
#else
#define GEMM(gi) pg8::gemm_phase<gi>(lds, ws, G, blk)
#endif
    volatile LAS unsigned* xst = (volatile LAS unsigned*)(lds + 131072);
    unsigned* barw = (unsigned*)ws;
    if (threadIdx.x < 2) xst[threadIdx.x] = 0u;
    if (blk == 0) for (int i = threadIdx.x; i < XCD_BAR_WORDS; i += 512) barw[i] = 0u;
    prologue<0>(p, lds, G, blk);
#ifdef PROBE_PRO2
    __syncthreads(); prologue<0>(p, lds, G, blk);
#endif
    grid.sync();
    XcdBarrier xbar = xcd_barrier_post(barw, xst);
    GEMM(0); GEMM(1); GEMM(2);
    if (blk >= G / 2) prologue<1>(p, lds, G, blk);
#ifdef PROBE_G012
    GEMM(0); GEMM(1); GEMM(2);
#endif
    GSYNC();
    attention_phase(p, lds, G, blk); GSYNC();
    GEMM(3); GEMM(4); GEMM(5); GSYNC();
    row_pass<true, false, true>((const bf16_t*)(ws + WS_MIX), p.x, ws + WS_XR, p.g_mix_post, p.g_mem_pre, (bf16_t*)(ws + WS_H), G, blk);
#ifdef PROBE_R12
    row_pass<true, false, true>((const bf16_t*)(ws + WS_MIX), p.x, ws + WS_XR, p.g_mix_post, p.g_mem_pre, (bf16_t*)(ws + WS_H), G, blk);
#endif
    GSYNC();
    GEMM(6); GSYNC();
    GEMM(7); GSYNC();
    row_pass<true, true, true>((const bf16_t*)(ws + WS_MEMO), ws + WS_XR, ws + WS_XR, p.g_mem_post, p.g_ffn_pre, (bf16_t*)(ws + WS_H), G, blk); GSYNC();
    GEMM(8);
#ifdef PROBE_G8
    GEMM(8);
#endif
    GSYNC();
    GEMM(9);
#ifdef PROBE_G9
    GEMM(9);
#endif
    GSYNC();
    row_pass<false, true, false>((const bf16_t*)(ws + WS_FO), ws + WS_XR, p.out, p.g_ffn_post, nullptr, nullptr, G, blk);
#undef GEMM
}

extern "C" void kernel_launch(void* const* d_in, const int* in_sizes, int n_in, void* d_out, int out_size, void* d_ws, size_t ws_size, hipStream_t stream) {
    static int grid_blocks = 0;
    if (grid_blocks == 0) {
        if (n_in != 23 || ws_size < WS_END) { fprintf(stderr, "kernel_launch: unexpected n_in %d / ws %zu\n", n_in, ws_size); grid_blocks = -1; return; }
        int dev = 0, cus = 0, per_cu = 0;
        hipGetDevice(&dev);
        hipDeviceGetAttribute(&cus, hipDeviceAttributeMultiprocessorCount, dev);
        if (hipFuncSetAttribute((const void*)fwd_megakernel, hipFuncAttributeMaxDynamicSharedMemorySize, LDS_BYTES) != hipSuccess) { fprintf(stderr, "kernel_launch: hipFuncSetAttribute failed\n"); }
        if (hipOccupancyMaxActiveBlocksPerMultiprocessor(&per_cu, (const void*)fwd_megakernel, 512, LDS_BYTES) != hipSuccess || per_cu < 1) { fprintf(stderr, "kernel_launch: occupancy query gave %d\n", per_cu); per_cu = 1; }
        (void)hipGetLastError();
        grid_blocks = cus * 1;
        if (grid_blocks > 256) grid_blocks = 256;
    }
    if (grid_blocks < 0) return;
    Params p{};
    const float* const* in = (const float* const*)d_in;
    p.x = in[0]; p.mem = in[1]; p.w_in = in[2]; p.w_out = in[3]; p.rel_bias = in[4];
    p.lq1 = in[5]; p.lk1 = in[6]; p.lq2 = in[7]; p.lk2 = in[8];
    p.diff_gain = in[9]; p.sb_gain = in[10]; p.g_mix_pre = in[11]; p.g_mix_post = in[12];
    p.w_mq = in[13]; p.w_mkv = in[14]; p.w_mo = in[15]; p.g_mem_kv = in[16]; p.g_mem_pre = in[17]; p.g_mem_post = in[18];
    p.w_gu = in[19]; p.w_down = in[20]; p.g_ffn_pre = in[21]; p.g_ffn_post = in[22];
    p.out = (float*)d_out; p.ws = (unsigned char*)d_ws;
    void* args[] = {&p};
    hipError_t e = hipLaunchCooperativeKernel((const void*)fwd_megakernel, dim3(grid_blocks), dim3(512), args, LDS_BYTES, stream);
    if (e != hipSuccess) fprintf(stderr, "cooperative launch failed: %s (grid %d)\n", hipGetErrorString(e), grid_blocks);
}
```

```cpp
#define USE_NT 1
#define GSYNC() xcd_barrier(xbar)
#include <hip/hip_runtime.h>
#include <hip/hip_cooperative_groups.h>
#include <cstdint>
#include <cstdio>
namespace cg = cooperative_groups;

#define LAS __attribute__((address_space(3)))
typedef unsigned short bf16_t;
typedef short bf16x8 __attribute__((ext_vector_type(8)));
typedef float f32x4 __attribute__((ext_vector_type(4)));
typedef float f32x16 __attribute__((ext_vector_type(16)));
typedef unsigned u32x4 __attribute__((ext_vector_type(4)));
typedef unsigned u32x2 __attribute__((ext_vector_type(2)));
typedef float f32x2_t __attribute__((ext_vector_type(2)));
typedef __bf16 bf16x2_t __attribute__((ext_vector_type(2)));

constexpr int NB = 8, SEQ = 4096, DM = 2048, MT = NB * SEQ, DFF = 5632;
constexpr float LOG2E = 1.4426950408889634f;
constexpr float EPS = 1e-6f;
constexpr size_t MiB = 1u << 20;
constexpr size_t WS_WQK = 2 * MiB, WS_WV = 18 * MiB, WS_WOUT = 26 * MiB, WS_WMQ = 34 * MiB, WS_WMKV = 42 * MiB, WS_WMO = 58 * MiB,
                 WS_WGU = 66 * MiB, WS_WDN = 110 * MiB, WS_MEMN = 132 * MiB, WS_KVM = 140 * MiB, WS_WKT = 156 * MiB, WS_VWT = 188 * MiB,
                 WS_H = 224 * MiB, WS_QK = 352 * MiB, WS_VT = 608 * MiB, WS_AO = 736 * MiB, WS_MIX = 352 * MiB, WS_S = 480 * MiB,
                 WS_P = 608 * MiB, WS_MEMO = 672 * MiB, WS_F = 352 * MiB, WS_FO = 704 * MiB, WS_KD = 864 * MiB, WS_KS = 928 * MiB, WS_XR = 864 * MiB  , WS_PARK = 992 * MiB, WS_END = 1008 * MiB;

struct Params {
    const float* x; const float* mem; const float* w_in; const float* w_out; const float* rel_bias;
    const float* lq1; const float* lk1; const float* lq2; const float* lk2;
    const float* diff_gain; const float* sb_gain; const float* g_mix_pre; const float* g_mix_post;
    const float* w_mq; const float* w_mkv; const float* w_mo; const float* g_mem_kv; const float* g_mem_pre; const float* g_mem_post;
    const float* w_gu; const float* w_down; const float* g_ffn_pre; const float* g_ffn_post;
    float* out; unsigned char* ws;
};

__device__ __forceinline__ unsigned cvtpk(float lo, float hi) { f32x2_t v = {lo, hi}; bf16x2_t b = __builtin_convertvector(v, bf16x2_t); return __builtin_bit_cast(unsigned, b); }
#ifdef USE_NT
#define NTL(p) __builtin_nontemporal_load(&(p))
#define NTS(v, p) __builtin_nontemporal_store((v), &(p))
#else
#define NTL(p) (p)
#define NTS(v, p) ((p) = (v))
#endif
__device__ __forceinline__ float bf_lo(unsigned u) { return __uint_as_float(u << 16); }
__device__ __forceinline__ float bf_hi(unsigned u) { return __uint_as_float(u & 0xffff0000u); }
__device__ __forceinline__ float wave_sum(float v) {
#pragma unroll
    for (int o = 1; o < 64; o <<= 1) v += __shfl_xor(v, o);
    return v;
}
__device__ __forceinline__ float wave_max(float v) {
#pragma unroll
    for (int o = 1; o < 64; o <<= 1) v = fmaxf(v, __shfl_xor(v, o));
    return v;
}
__device__ __forceinline__ float ex2(float v) { return __builtin_amdgcn_exp2f(v); }
__device__ __forceinline__ float lg2(float v) { return __builtin_amdgcn_logf(v); }

namespace pg8 {
constexpr int BM = 256, BK = 64, HALF = 128, HTB = HALF * BK * 2, STAGE_BYTES = 8 * HTB;
__device__ __forceinline__ int lds_byte(int r, int c) { const int st = (r >> 4) * 2 + (c >> 5), rr = r & 15, cc = c & 31, ob = rr * 64 + cc * 2; return st * 1024 + (ob ^ (((ob >> 9) & 1) << 5)); }
__device__ __forceinline__ void stage_rc(int b, int& R, int& C) { const int st = b / 1024, sb = b % 1024, swz = sb ^ (((sb >> 9) & 1) << 5); R = (st >> 1) * 16 + swz / 64; C = (st & 1) * 32 + (swz % 64) / 2; }
__device__ __forceinline__ int perm32(int rho) { const int n = rho >> 4, i = rho & 15; return 8 * (i >> 2) + 4 * n + (i & 3); }

struct GUnit { const char* A; const char* B; char* C; int SA, SR, SB, SX; float scale; };

struct GemmDesc {
    size_t A, B, C;
    int K, lda, ldb, ldc;
    int nM, nN;
    int kind, mode;
    int scale_kind;
    float scale;
    size_t a_tile, b_tile, b_batch, c_rt, c_ct;
    size_t a_b, a_h, a_t, b_b, b_h, b_t, c_b, c_h, c_t;
};

constexpr GemmDesc make_desc(int gi) {
    GemmDesc d{};
    d.scale = 1.0f; d.kind = 0; d.mode = 0; d.scale_kind = 0;
    switch (gi) {
    case 0:
        d.A = WS_H; d.B = WS_WQK; d.C = WS_QK;
        d.K = 2048; d.lda = 2048; d.ldb = 2048; d.ldc = 4096; d.nM = 128; d.nN = 16; d.scale_kind = 1;
        d.a_tile = (size_t)256 * 2048 * 2; d.b_tile = (size_t)256 * 2048 * 2; d.c_rt = (size_t)256 * 4096 * 2; d.c_ct = 512; break;
    case 1:
        d.A = WS_WV; d.B = WS_H; d.C = WS_VT;
        d.K = 2048; d.lda = 2048; d.ldb = 2048; d.ldc = MT; d.nM = 8; d.nN = 128; d.scale_kind = 2;
        d.a_tile = (size_t)256 * 2048 * 2; d.b_tile = (size_t)256 * 2048 * 2; d.c_rt = (size_t)256 * MT * 2; d.c_ct = 512; break;
    case 2:
        d.A = WS_MEMN; d.B = WS_WMKV; d.C = WS_KVM;
        d.K = 2048; d.lda = 2048; d.ldb = 2048; d.ldc = 4096; d.nM = 8; d.nN = 16;
        d.a_tile = (size_t)256 * 2048 * 2; d.b_tile = (size_t)256 * 2048 * 2; d.c_rt = (size_t)256 * 4096 * 2; d.c_ct = 512; break;
    case 3:
        d.A = WS_AO; d.B = WS_WOUT; d.C = WS_MIX;
        d.K = 2048; d.lda = 2048; d.ldb = 2048; d.ldc = 2048; d.nM = 128; d.nN = 8;
        d.a_tile = (size_t)256 * 2048 * 2; d.b_tile = (size_t)256 * 2048 * 2; d.c_rt = (size_t)256 * 2048 * 2; d.c_ct = 512; break;
    case 4:
        d.kind = 1; d.A = WS_KVM; d.B = WS_WMQ; d.C = WS_WKT;
        d.K = 512; d.lda = 4096; d.ldb = 2048; d.ldc = 2048; d.scale = 0.04419417382415922f * LOG2E;
        d.a_b = (size_t)256 * 4096 * 2; d.a_h = 1024; d.a_t = 0;
        d.b_b = 0; d.b_h = 1024; d.b_t = (size_t)256 * 2048 * 2;
        d.c_b = (size_t)1024 * 2048 * 2; d.c_h = (size_t)256 * 2048 * 2; d.c_t = 512; break;
    case 5:
        d.kind = 1; d.A = WS_WMO; d.B = WS_KVM + 4096; d.C = WS_VWT;
        d.K = 512; d.lda = 2048; d.ldb = 4096; d.ldc = 1024;
        d.a_b = 0; d.a_h = 1024; d.a_t = (size_t)256 * 2048 * 2;
        d.b_b = (size_t)256 * 4096 * 2; d.b_h = 1024; d.b_t = 0;
        d.c_b = (size_t)2048 * 1024 * 2; d.c_h = 512; d.c_t = (size_t)256 * 1024 * 2; break;
    case 6:
        d.A = WS_H; d.B = WS_WKT; d.C = WS_P; d.mode = 3;
        d.K = 2048; d.lda = 2048; d.ldb = 2048; d.ldc = 1024; d.nM = 128; d.nN = 4;
        d.a_tile = (size_t)256 * 2048 * 2; d.b_tile = (size_t)256 * 2048 * 2; d.b_batch = (size_t)1024 * 2048 * 2; d.c_rt = (size_t)256 * 1024 * 2; d.c_ct = 512; break;
    case 7:
        d.A = WS_P; d.B = WS_VWT; d.C = WS_MEMO;
        d.K = 1024; d.lda = 1024; d.ldb = 1024; d.ldc = 2048; d.nM = 128; d.nN = 8;
        d.a_tile = (size_t)256 * 1024 * 2; d.b_tile = (size_t)256 * 1024 * 2; d.b_batch = (size_t)2048 * 1024 * 2; d.c_rt = (size_t)256 * 2048 * 2; d.c_ct = 512; break;
    case 8:
        d.A = WS_H; d.B = WS_WGU; d.C = WS_F; d.mode = 2;
        d.K = 2048; d.lda = 2048; d.ldb = 2048; d.ldc = DFF; d.nM = 128; d.nN = 44;
        d.a_tile = (size_t)256 * 2048 * 2; d.b_tile = (size_t)256 * 2048 * 2; d.c_rt = (size_t)256 * DFF * 2; d.c_ct = 256; break;
    default:
        d.A = WS_F; d.B = WS_WDN; d.C = WS_FO;
        d.K = DFF; d.lda = DFF; d.ldb = DFF; d.ldc = 2048; d.nM = 128; d.nN = 8;
        d.a_tile = (size_t)256 * DFF * 2; d.b_tile = (size_t)256 * DFF * 2; d.c_rt = (size_t)256 * 2048 * 2; d.c_ct = 512; break;
    }
    return d;
}

template <int GI>
__device__ __forceinline__ bool sched_next(unsigned char* ws, int i, int G, int c, GUnit& u) {
    constexpr GemmDesc d = make_desc(GI);
    const int L = i * G + c;
    u.SA = 128 * d.ldc; u.SR = d.ldc; u.SB = 128; u.SX = 64; u.scale = d.scale;
    if (d.kind == 0) {
        constexpr int nwg = d.nM * d.nN;
        if (L >= nwg) return false;
        int wgid = L;
        { constexpr int q = nwg / 8, r = nwg % 8; const int xcd = wgid % 8, off = wgid / 8; wgid = (xcd < r ? xcd * (q + 1) : r * (q + 1) + (xcd - r) * q) + off; }
        constexpr int nig = 8 * d.nN; const int gid = wgid / nig, fm = gid * 8, gsz = (d.nM - fm) < 8 ? (d.nM - fm) : 8;
        const int pm = fm + ((wgid % nig) % gsz), pn = (wgid % nig) / gsz;
        u.A = (const char*)ws + d.A + (size_t)pm * d.a_tile;
        u.B = (const char*)ws + d.B + (size_t)(pm >> 4) * d.b_batch + (size_t)pn * d.b_tile;
        u.C = (char*)ws + d.C + (size_t)pm * d.c_rt + (size_t)pn * d.c_ct;
        if (d.scale_kind == 1) {
            u.scale = (pn < 4) ? 0.125f * LOG2E : ((pn >= 8 && pn < 12) ? 0.08838834764831845f * LOG2E : 1.0f);
            if (pn >= 4 && pn < 8) {
                u.C = (char*)ws + WS_KD + ((size_t)(4 * (pn - 4)) * MT + (size_t)pm * 256) * 64 * 2;
                u.SA = 128 * 64; u.SR = 64; u.SB = 2 * MT * 64; u.SX = MT * 64;
            } else if (pn >= 12) {
                u.C = (char*)ws + WS_KS + ((size_t)(2 * (pn - 12)) * MT + (size_t)pm * 256) * 128 * 2;
                u.SA = 128 * 128; u.SR = 128; u.SB = MT * 128; u.SX = 64;
            }
        } else if (d.scale_kind == 2) {
            u.C = (char*)ws + WS_VT + ((size_t)(2 * pm) * 512 + (size_t)(4 * pn)) * 8192 * 2;
            u.SA = 512 * 8192; u.SR = 64; u.SB = 2 * 8192; u.SX = 8192;
        }
        return true;
    } else {
        if (L >= 256) return false;
        const int z = L >> 3, t = L & 7, b = z >> 2, h = z & 3;
        u.A = (const char*)ws + d.A + (size_t)b * d.a_b + (size_t)h * d.a_h + (size_t)t * d.a_t;
        u.B = (const char*)ws + d.B + (size_t)b * d.b_b + (size_t)h * d.b_h + (size_t)t * d.b_t;
        u.C = (char*)ws + d.C + (size_t)b * d.c_b + (size_t)h * d.c_h + (size_t)t * d.c_t;
        return true;
    }
}

template <int mode>
__device__ __forceinline__ void epilogue(f32x4 (&acc)[2][2][4][2], const GUnit& u, int wr, int wc, int fr, int fq, LAS unsigned char* lds) {
    if (mode == 0) {
        bf16_t* base = (bf16_t*)u.C; const float sc = u.scale;
#pragma unroll
        for (int ai = 0; ai < 2; ++ai)
#pragma unroll
            for (int m = 0; m < 4; ++m) {
                bf16_t* rowp = base + (size_t)ai * u.SA + (size_t)(wr * 64 + m * 16 + fr) * u.SR + (wc >> 1) * u.SX + (wc & 1) * 32 + 8 * fq;
#pragma unroll
                for (int bj = 0; bj < 2; ++bj) {
                    const f32x4 v0 = acc[ai][bj][m][0] * sc, v1 = acc[ai][bj][m][1] * sc;
                    u32x4 w; w.x = cvtpk(v0[0], v0[1]); w.y = cvtpk(v0[2], v0[3]); w.z = cvtpk(v1[0], v1[1]); w.w = cvtpk(v1[2], v1[3]);
                    *(u32x4*)(rowp + (size_t)bj * u.SB) = w;
                }
            }
    } else if (mode == 1) {
        float* base = (float*)u.C; const float sc = u.scale;
#pragma unroll
        for (int ai = 0; ai < 2; ++ai)
#pragma unroll
            for (int m = 0; m < 4; ++m) {
                float* rowp = base + (size_t)ai * u.SA + (size_t)(wr * 64 + m * 16 + fr) * u.SR + (wc >> 1) * u.SX + (wc & 1) * 32 + 8 * fq;
#pragma unroll
                for (int bj = 0; bj < 2; ++bj) {
                    *(f32x4*)(rowp + (size_t)bj * u.SB) = acc[ai][bj][m][0] * sc;
                    *(f32x4*)(rowp + (size_t)bj * u.SB + 4) = acc[ai][bj][m][1] * sc;
                }
            }
    } else if (mode == 3) {
        LAS f32x2_t* X = (LAS f32x2_t*)(lds + 131200);
#pragma unroll
        for (int ai = 0; ai < 2; ++ai)
#pragma unroll
            for (int m = 0; m < 4; ++m) {
                float mx = -1e30f;
#pragma unroll
                for (int bj = 0; bj < 2; ++bj)
#pragma unroll
                    for (int n = 0; n < 2; ++n) { const f32x4 v = acc[ai][bj][m][n]; mx = fmaxf(mx, fmaxf(fmaxf(v[0], v[1]), fmaxf(v[2], v[3]))); }
                mx = fmaxf(mx, __shfl_xor(mx, 16)); mx = fmaxf(mx, __shfl_xor(mx, 32));
                float sum = 0.f;
#pragma unroll
                for (int bj = 0; bj < 2; ++bj)
#pragma unroll
                    for (int n = 0; n < 2; ++n) { f32x4 v = acc[ai][bj][m][n]; v[0] = ex2(v[0] - mx); v[1] = ex2(v[1] - mx); v[2] = ex2(v[2] - mx); v[3] = ex2(v[3] - mx);
                        acc[ai][bj][m][n] = v; sum += (v[0] + v[1]) + (v[2] + v[3]); }
                sum += __shfl_xor(sum, 16); sum += __shfl_xor(sum, 32);
                if (fq == 0) X[(ai * HALF + wr * 64 + m * 16 + fr) * 4 + wc] = (f32x2_t){mx, sum};
            }
        asm volatile("s_waitcnt lgkmcnt(0)" ::: "memory"); __builtin_amdgcn_s_barrier(); asm volatile("" ::: "memory");
        bf16_t* base = (bf16_t*)u.C;
#pragma unroll
        for (int ai = 0; ai < 2; ++ai)
#pragma unroll
            for (int m = 0; m < 4; ++m) {
                const int row = ai * HALF + wr * 64 + m * 16 + fr;
                const f32x2_t a0 = X[row * 4 + 0], a1 = X[row * 4 + 1], a2 = X[row * 4 + 2], a3 = X[row * 4 + 3];
                const float M = fmaxf(fmaxf(a0.x, a1.x), fmaxf(a2.x, a3.x));
                const float tot = (a0.y * ex2(a0.x - M) + a1.y * ex2(a1.x - M)) + (a2.y * ex2(a2.x - M) + a3.y * ex2(a3.x - M));
                const float own = (wc == 0) ? a0.x : (wc == 1) ? a1.x : (wc == 2) ? a2.x : a3.x;
                const float f = ex2(own - M) / tot;
                bf16_t* rowp = base + (size_t)ai * u.SA + (size_t)(wr * 64 + m * 16 + fr) * u.SR + (wc >> 1) * u.SX + (wc & 1) * 32 + 8 * fq;
#pragma unroll
                for (int bj = 0; bj < 2; ++bj) {
                    const f32x4 v0 = acc[ai][bj][m][0] * f, v1 = acc[ai][bj][m][1] * f;
                    u32x4 w; w.x = cvtpk(v0[0], v0[1]); w.y = cvtpk(v0[2], v0[3]); w.z = cvtpk(v1[0], v1[1]); w.w = cvtpk(v1[2], v1[3]);
                    *(u32x4*)(rowp + (size_t)bj * u.SB) = w;
                }
            }
    } else {
        bf16_t* base = (bf16_t*)u.C;
#pragma unroll
        for (int ai = 0; ai < 2; ++ai)
#pragma unroll
            for (int m = 0; m < 4; ++m) {
                bf16_t* rowp = base + (size_t)ai * u.SA + (size_t)(wr * 64 + m * 16 + fr) * u.SR + (wc >> 1) * u.SX + (wc & 1) * 32 + 8 * fq;
                float y[8];
#pragma unroll
                for (int n = 0; n < 2; ++n)
#pragma unroll
                    for (int j = 0; j < 4; ++j) {
                        const float g = acc[ai][0][m][n][j], up = acc[ai][1][m][n][j];
                        y[n * 4 + j] = g * __builtin_amdgcn_rcpf(1.0f + ex2(-g * LOG2E)) * up;
                    }
                u32x4 w; w.x = cvtpk(y[0], y[1]); w.y = cvtpk(y[2], y[3]); w.z = cvtpk(y[4], y[5]); w.w = cvtpk(y[6], y[7]);
                *(u32x4*)rowp = w;
            }
    }
}

template <int GI>
__device__ __forceinline__ void gemm_phase(LAS unsigned char* lds, unsigned char* ws, int G, int cblk) {
    constexpr GemmDesc g = make_desc(GI);
    int tid_ = threadIdx.x; asm volatile("" : "+v"(tid_));
    const int tid = tid_, wid = __builtin_amdgcn_readfirstlane(tid >> 6), lane = tid & 63, wr = wid >> 2, wc = wid & 3, fr = lane & 15, fq = lane >> 4;
    constexpr int K = g.K, nt = K / BK, lda = g.lda, ldb = g.ldb;
    unsigned voffA[2], voffB[2];
#pragma unroll
    for (int i = 0; i < 2; ++i) { int R, C; stage_rc(tid * 16 + i * 8192, R, C); const int Rb = (R & ~31) + perm32(R & 31);
        voffA[i] = (unsigned)(R * lda + C) * 2u; voffB[i] = (unsigned)(Rb * ldb + C) * 2u; }
    const size_t kstep = (size_t)(BK * 2);
    const size_t hstepA = (size_t)HALF * lda * 2, hstepB = (size_t)HALF * ldb * 2;
    const unsigned ldsw = (unsigned)wid * 1024u;
    const int aoff = lds_byte(wr * 64 + fr, fq * 8), boff = lds_byte(wc * 32 + fr, fq * 8);
#define PG8_SA(b, h) (((b) * 2 + (h)) * HTB)
#define PG8_SB(b, h) ((4 + (b) * 2 + (h)) * HTB)
#define PG8_STAGE(bufoff, gbase, voff) do { _Pragma("unroll") for (int _i = 0; _i < 2; ++_i) \
        __builtin_amdgcn_global_load_lds((const unsigned*)((const char*)(gbase) + (voff)[_i]), (LAS unsigned*)(lds + (bufoff) + ldsw + _i * 8192), 16, 0, 0); } while (0)
#define PG8_LDA(dst, b, h) do { _Pragma("unroll") for (int m = 0; m < 4; ++m) _Pragma("unroll") for (int k = 0; k < 2; ++k) dst[m][k] = *(const LAS bf16x8*)(lds + PG8_SA(b, h) + aoff + m * 2048 + k * 1024); } while (0)
#define PG8_LDB(dst, b, h) do { _Pragma("unroll") for (int n = 0; n < 2; ++n) _Pragma("unroll") for (int k = 0; k < 2; ++k) dst[n][k] = *(const LAS bf16x8*)(lds + PG8_SB(b, h) + boff + n * 2048 + k * 1024); } while (0)
#define PG8_MMA(ai, bj, At, Bt) do { __builtin_amdgcn_s_setprio(1); _Pragma("unroll") for (int m = 0; m < 4; ++m) _Pragma("unroll") for (int n = 0; n < 2; ++n) _Pragma("unroll") for (int k = 0; k < 2; ++k) \
        acc[ai][bj][m][n] = __builtin_amdgcn_mfma_f32_16x16x32_bf16(Bt[n][k], At[m][k], acc[ai][bj][m][n], 0, 0, 0); __builtin_amdgcn_s_setprio(0); } while (0)
#define PG8_WAIT_V(n) asm volatile("s_waitcnt vmcnt(" #n ")" ::: "memory")
#define PG8_WAIT_L(n) asm volatile("s_waitcnt lgkmcnt(" #n ")" ::: "memory")
#define PG8_BAR __builtin_amdgcn_s_barrier()
#define PG8_SCHED __builtin_amdgcn_sched_barrier(0)
    GUnit cur, nxt; int ui = 0;
    if (!sched_next<GI>(ws, 0, G, cblk, cur)) return;
    f32x4 acc[2][2][4][2];
#pragma unroll
    for (int a = 0; a < 2; ++a)
#pragma unroll
        for (int b = 0; b < 2; ++b)
#pragma unroll
            for (int m = 0; m < 4; ++m)
#pragma unroll
                for (int n = 0; n < 2; ++n) acc[a][b][m][n] = (f32x4){0.f, 0.f, 0.f, 0.f};
    bf16x8 At[4][2], B0[2][2], B1[2][2];
    const char* cA = cur.A; const char* cB = cur.B;
    PG8_STAGE(PG8_SB(0, 0), cB, voffB); PG8_STAGE(PG8_SB(0, 1), cB + hstepB, voffB); PG8_STAGE(PG8_SA(0, 0), cA, voffA); PG8_STAGE(PG8_SA(0, 1), cA + hstepA, voffA);
    if (wr == 1) PG8_BAR;
    PG8_WAIT_V(2); PG8_BAR;
    PG8_STAGE(PG8_SB(1, 0), cB + kstep, voffB); PG8_STAGE(PG8_SA(1, 0), cA + kstep, voffA); PG8_STAGE(PG8_SB(1, 1), cB + hstepB + kstep, voffB);
    PG8_WAIT_V(6); PG8_BAR;
    for (;;) {
        const bool has_next = sched_next<GI>(ws, ui + 1, G, cblk, nxt);
        const char* nA = has_next ? nxt.A : cA; const char* nB = has_next ? nxt.B : cB;
        for (int t = 0; t < nt; t += 2) {
            const bool last = (t == nt - 2);
            const char* a1 = cA + (size_t)(t + 1) * kstep;
            const char* a2 = last ? nA : cA + (size_t)(t + 2) * kstep; const char* b2 = last ? nB : cB + (size_t)(t + 2) * kstep;
            const char* a3 = a2 + kstep; const char* b3 = b2 + kstep;
            PG8_LDB(B0, 0, 0); PG8_LDB(B1, 0, 1); PG8_SCHED; PG8_LDA(At, 0, 0); PG8_STAGE(PG8_SA(1, 1), a1 + hstepA, voffA);
            PG8_WAIT_V(8); PG8_WAIT_L(0); PG8_BAR; PG8_MMA(0, 0, At, B0); PG8_MMA(0, 1, At, B1); PG8_BAR; PG8_SCHED;
            PG8_LDA(At, 0, 1); PG8_STAGE(PG8_SB(0, 0), b2, voffB); PG8_STAGE(PG8_SB(0, 1), b2 + hstepB, voffB); PG8_STAGE(PG8_SA(0, 0), a2, voffA);
            PG8_WAIT_V(8); PG8_WAIT_L(0); PG8_BAR; PG8_MMA(1, 0, At, B0); PG8_MMA(1, 1, At, B1); PG8_BAR; PG8_SCHED;
            PG8_LDB(B0, 1, 0); PG8_LDB(B1, 1, 1); PG8_SCHED; PG8_LDA(At, 1, 0); PG8_STAGE(PG8_SA(0, 1), a2 + hstepA, voffA);
            PG8_WAIT_V(8); PG8_WAIT_L(0); PG8_BAR; PG8_MMA(0, 0, At, B0); PG8_MMA(0, 1, At, B1); PG8_BAR; PG8_SCHED;
            PG8_LDA(At, 1, 1); PG8_STAGE(PG8_SB(1, 0), b3, voffB); PG8_STAGE(PG8_SB(1, 1), b3 + hstepB, voffB); PG8_STAGE(PG8_SA(1, 0), a3, voffA);
            PG8_WAIT_V(8); PG8_WAIT_L(0); PG8_BAR; PG8_MMA(1, 0, At, B0); PG8_MMA(1, 1, At, B1); PG8_BAR; PG8_SCHED;
        }
        if (wr == 0) PG8_BAR;
        epilogue<g.mode>(acc, cur, wr, wc, fr, fq, lds);
        if (!has_next) break;
#pragma unroll
        for (int a = 0; a < 2; ++a)
#pragma unroll
            for (int b = 0; b < 2; ++b)
#pragma unroll
                for (int m = 0; m < 4; ++m)
#pragma unroll
                    for (int n = 0; n < 2; ++n) acc[a][b][m][n] = (f32x4){0.f, 0.f, 0.f, 0.f};
        cur = nxt; cA = nA; cB = nB; ++ui;
        if (wr == 1) PG8_BAR;
    }
    PG8_WAIT_V(0);
    PG8_BAR;
#undef PG8_SA
#undef PG8_SB
#undef PG8_STAGE
#undef PG8_LDA
#undef PG8_LDB
#undef PG8_MMA
#undef PG8_WAIT_V
#undef PG8_WAIT_L
#undef PG8_BAR
#undef PG8_SCHED
}
}

#define XB_TMO      128
#define XB_XCNT(j)  (256  + 64 * (j))
#define XB_XSUB(j)  (1280 + 64 * (j))
#define XB_XGEN(j)  (2304 + 64 * (j))
#define XB_TOP      3328
#define XB_TOPGEN   3392
#define XCD_BAR_WORDS 3456
#define XB_SPIN_CAP (1u << 18)

__device__ __forceinline__ unsigned xb_ld(unsigned* p)              { return __hip_atomic_load(p, __ATOMIC_RELAXED, __HIP_MEMORY_SCOPE_AGENT); }
__device__ __forceinline__ unsigned xb_add(unsigned* p, unsigned v) { return __hip_atomic_fetch_add(p, v, __ATOMIC_RELAXED, __HIP_MEMORY_SCOPE_AGENT); }
__device__ __forceinline__ unsigned xb_xcc_id() { return (unsigned)__builtin_amdgcn_s_getreg((3 << 11) | 20) & 0xFu; }
#define XB_SPIN(cond, bar) do { unsigned _sp = 0; while (cond) { __builtin_amdgcn_s_sleep(1); \
    if ((++_sp & 255u) == 0u) { if (xb_ld(&(bar)[XB_TMO])) break; if (_sp > XB_SPIN_CAP) { atomicAdd(&(bar)[XB_TMO], 1u); break; } } } } while (0)

struct XcdBarrier {
    unsigned* bar; unsigned x;
    volatile LAS unsigned* st;
};

__device__ __forceinline__ XcdBarrier xcd_barrier_post(unsigned* bar, volatile LAS unsigned* st) {
    XcdBarrier b; b.bar = bar; b.x = xb_xcc_id(); b.st = st;
    if (threadIdx.x == 0) (void)xb_add(&bar[XB_XCNT(b.x)], 1u);
    return b;
}
__device__ __forceinline__ void xcd_barrier_complete(unsigned* bar, unsigned x, unsigned& nloc, unsigned& nx) {
    const unsigned G = gridDim.x * gridDim.y * gridDim.z;
    unsigned sum, cnt, mine, sp = 0u;
    for (;;) {
        sum = 0u; cnt = 0u; mine = 0u;
#pragma unroll
        for (unsigned j = 0; j < 16; ++j) { const unsigned c = xb_ld(&bar[XB_XCNT(j)]); sum += c; cnt += (c > 0u) ? 1u : 0u; mine = (j == x) ? c : mine; }
        if (sum == G) break;
        __builtin_amdgcn_s_sleep(1);
        if ((++sp & 255u) == 0u) { if (xb_ld(&bar[XB_TMO])) break; if (sp > XB_SPIN_CAP) { atomicAdd(&bar[XB_TMO], 1u); break; } }
    }
    nloc = mine > 0u ? mine : 1u; nx = cnt > 0u ? cnt : 1u;
}

__device__ __forceinline__ void xcd_barrier(const XcdBarrier& b) {
    asm volatile("s_waitcnt vmcnt(0)" ::: "memory");
    __syncthreads();
    if (threadIdx.x == 0) {
        unsigned* bar = b.bar;
        __builtin_amdgcn_s_waitcnt(0);
        unsigned nloc = b.st[0], nx = b.st[1];
        if (nloc == 0u) { xcd_barrier_complete(bar, b.x, nloc, nx); b.st[0] = nloc; b.st[1] = nx; }
        const unsigned old = xb_add(&bar[XB_XSUB(b.x)], 1u);
        const unsigned gen = old / nloc;
        if (old + 1u == (gen + 1u) * nloc) {
            __builtin_amdgcn_fence(__ATOMIC_RELEASE, "agent");
            asm volatile("s_waitcnt vmcnt(0)" ::: "memory");
            const unsigned og = xb_add(&bar[XB_TOP], 1u);
            const unsigned tg = og / nx;
            if (og + 1u == (tg + 1u) * nx) xb_add(&bar[XB_TOPGEN], 1u);
            else XB_SPIN(xb_ld(&bar[XB_TOPGEN]) == tg, bar);
            __builtin_amdgcn_fence(__ATOMIC_ACQUIRE, "agent");
            xb_add(&bar[XB_XGEN(b.x)], 1u);
            asm volatile("s_waitcnt vmcnt(0)" ::: "memory");
        } else {
            XB_SPIN(xb_ld(&bar[XB_XGEN(b.x)]) == gen, bar);
            __builtin_amdgcn_fence(__ATOMIC_ACQUIRE, "agent");
            asm volatile("s_waitcnt vmcnt(0)" ::: "memory");
        }
    }
    __syncthreads();
}

__device__ __forceinline__ void tr_item(const float* W, int N, int K, int k0, int n0, bf16_t* dst, LAS float* scr, int lane) {
#pragma unroll 8
    for (int i = 0; i < 32; ++i) { const int kk = 2 * i + (lane >> 5); scr[kk * 33 + (lane & 31)] = NTL(W[(size_t)(k0 + kk) * N + n0 + (lane & 31)]); }
    asm volatile("s_waitcnt lgkmcnt(0)" ::: "memory");
    const int c = lane & 7;
#pragma unroll
    for (int j = 0; j < 4; ++j) { const int n = (lane >> 3) + 8 * j; const LAS float* s = scr + (8 * c) * 33 + n;
        u32x4 o; o.x = cvtpk(s[0 * 33], s[1 * 33]); o.y = cvtpk(s[2 * 33], s[3 * 33]); o.z = cvtpk(s[4 * 33], s[5 * 33]); o.w = cvtpk(s[6 * 33], s[7 * 33]);
        *(u32x4*)(dst + (size_t)n * K + k0 + 8 * c) = o; }
    asm volatile("s_waitcnt lgkmcnt(0)" ::: "memory");
}

__device__ __forceinline__ void rms_row_bf16(const float* xrow, const float* g, bf16_t* orow, int lane) {
    const f32x4* xr = (const f32x4*)xrow + lane;
    f32x4 v[8]; float s = 0.f;
#pragma unroll
    for (int j = 0; j < 8; ++j) { v[j] = NTL(xr[64 * j]); s += (v[j].x * v[j].x + v[j].y * v[j].y) + (v[j].z * v[j].z + v[j].w * v[j].w); }
    const float r = 1.0f / sqrtf(wave_sum(s) * (1.0f / DM) + EPS);
    const f32x4* gr = (const f32x4*)g + lane;
    u32x2* o8 = (u32x2*)orow + lane;
#pragma unroll
    for (int j = 0; j < 8; ++j) { const f32x4 gv = gr[64 * j]; u32x2 w; w.x = cvtpk(v[j].x * r * gv.x, v[j].y * r * gv.y); w.y = cvtpk(v[j].z * r * gv.z, v[j].w * r * gv.w); o8[64 * j] = w; }
}

template <int PART>
__device__ __forceinline__ void prologue(const Params& p, LAS unsigned char* lds, int G, int blk) {
    const int tid = threadIdx.x, lane = tid & 63, wave = __builtin_amdgcn_readfirstlane(tid >> 6);
    LAS float* scr = (LAS float*)(lds + wave * 16384);
    const int gw = (PART == 0 ? blk : blk - G / 2) * 8 + wave, NGW = (PART == 0 ? G : G - G / 2) * 8;
    unsigned char* ws = p.ws;
    bf16_t* Wqk = (bf16_t*)(ws + WS_WQK); bf16_t* Wv = (bf16_t*)(ws + WS_WV); bf16_t* Wout = (bf16_t*)(ws + WS_WOUT);
    bf16_t* Wmkv = (bf16_t*)(ws + WS_WMKV); bf16_t* Wmo = (bf16_t*)(ws + WS_WMO); bf16_t* Wgu = (bf16_t*)(ws + WS_WGU); bf16_t* Wdn = (bf16_t*)(ws + WS_WDN);
    constexpr int I0 = 32 * 192, I1 = 32 * 64, I2 = 32 * 128, I3 = 32 * 64, I4 = 32 * 352, I5 = 88 * 64;
    constexpr int NA = I0 + I1 + I2 + I3, NIT = NA + I4 + I5;
    for (int it = (PART == 0 ? 0 : NA) + gw; it < (PART == 0 ? NA : NIT); it += NGW) {
        int r = it;
        if (r < I0) { const int kb = r / 192, nb = r % 192, n0 = nb * 32; bf16_t* dst;
            if (n0 < 2048) dst = Wqk + (size_t)n0 * 2048;
            else if (n0 < 3072) dst = Wv + (size_t)(n0 - 2048) * 2048;
            else if (n0 < 5120) dst = Wqk + (size_t)(2048 + n0 - 3072) * 2048;
            else dst = Wv + (size_t)(1024 + n0 - 5120) * 2048;
            tr_item(p.w_in, 6144, 2048, kb * 64, n0, dst, scr, lane); continue; }
        r -= I0;
        if (r < I1) { const int kb = r / 64, nb = r % 64; tr_item(p.w_out, 2048, 2048, kb * 64, nb * 32, Wout + (size_t)(nb * 32) * 2048, scr, lane); continue; }
        r -= I1;
        if (r < I2) { const int kb = r / 128, nb = r % 128; tr_item(p.w_mkv, 4096, 2048, kb * 64, nb * 32, Wmkv + (size_t)(nb * 32) * 2048, scr, lane); continue; }
        r -= I2;
        if (r < I3) { const int kb = r / 64, nb = r % 64; tr_item(p.w_mo, 2048, 2048, kb * 64, nb * 32, Wmo + (size_t)(nb * 32) * 2048, scr, lane); continue; }
        r -= I3;
        if (r < I4) { const int kb = r / 352, nb = r % 352, n0 = nb * 32; int drow;
            if (n0 < DFF) drow = 256 * (n0 / 128) + (n0 % 128); else { const int c2 = n0 - DFF; drow = 256 * (c2 / 128) + 128 + (c2 % 128); }
            tr_item(p.w_gu, 2 * DFF, 2048, kb * 64, n0, Wgu + (size_t)drow * 2048, scr, lane); continue; }
        r -= I4;
        { const int kb = r / 64, nb = r % 64; tr_item(p.w_down, 2048, DFF, kb * 64, nb * 32, Wdn + (size_t)(nb * 32) * DFF, scr, lane); }
    }
    if (PART == 1) return;
    { bf16_t* Wmq = (bf16_t*)(ws + WS_WMQ); const int gt = blk * 512 + tid, NGT = G * 512;
      for (int i = gt; i < 2048 * 2048 / 4; i += NGT) { const f32x4 v = NTL(((const f32x4*)p.w_mq)[i]); u32x2 w; w.x = cvtpk(v.x, v.y); w.y = cvtpk(v.z, v.w); ((u32x2*)Wmq)[i] = w; } }
    bf16_t* H = (bf16_t*)(ws + WS_H); bf16_t* memn = (bf16_t*)(ws + WS_MEMN);
    for (int m = gw; m < MT; m += NGW) rms_row_bf16(p.x + (size_t)m * DM, p.g_mix_pre, H + (size_t)m * DM, lane);
    for (int m = gw; m < NB * 256; m += NGW) rms_row_bf16(p.mem + (size_t)m * DM, p.g_mem_kv, memn + (size_t)m * DM, lane);
}

template <bool HAS_H, bool XIN_BF, bool XOUT_BF>
__device__ __forceinline__ void row_pass(const bf16_t* y, const void* xin, void* xout, const float* g_post, const float* g_pre, bf16_t* hout, int G, int blk) {
    const int tid = threadIdx.x, lane = tid & 63, wave = tid >> 6;
    const int gw = blk * 8 + wave, NGW = G * 8;
    for (int row = gw; row < MT; row += NGW) {
        const u32x2* yr = (const u32x2*)(y + (size_t)row * DM) + lane;
        const f32x4* xr = (const f32x4*)((const float*)xin + (size_t)row * DM) + lane;
        const u32x2* xrb = (const u32x2*)((const bf16_t*)xin + (size_t)row * DM) + lane;
        f32x4 yv[8], xv[8]; float s = 0.f;
#pragma unroll
        for (int j = 0; j < 8; ++j) { const u32x2 w = NTL(yr[64 * j]); yv[j] = (f32x4){bf_lo(w.x), bf_hi(w.x), bf_lo(w.y), bf_hi(w.y)};
            if (XIN_BF) { const u32x2 xw = NTL(xrb[64 * j]); xv[j] = (f32x4){bf_lo(xw.x), bf_hi(xw.x), bf_lo(xw.y), bf_hi(xw.y)}; } else xv[j] = NTL(xr[64 * j]);
            s += (yv[j].x * yv[j].x + yv[j].y * yv[j].y) + (yv[j].z * yv[j].z + yv[j].w * yv[j].w); }
        const float r = 1.0f / sqrtf(wave_sum(s) * (1.0f / DM) + EPS);
        const f32x4* gp = (const f32x4*)g_post + lane;
        f32x4* xo = (f32x4*)((float*)xout + (size_t)row * DM) + lane;
        u32x2* xob = (u32x2*)((bf16_t*)xout + (size_t)row * DM) + lane;
        float s1 = 0.f;
#pragma unroll
        for (int j = 0; j < 8; ++j) { const f32x4 gv = gp[64 * j]; xv[j] = xv[j] + yv[j] * r * gv;
            if (XOUT_BF) { u32x2 w; w.x = cvtpk(xv[j].x, xv[j].y); w.y = cvtpk(xv[j].z, xv[j].w); NTS(w, xob[64 * j]); } else NTS(xv[j], xo[64 * j]);
            s1 += (xv[j].x * xv[j].x + xv[j].y * xv[j].y) + (xv[j].z * xv[j].z + xv[j].w * xv[j].w); }
        if (HAS_H) {
            const float r1 = 1.0f / sqrtf(wave_sum(s1) * (1.0f / DM) + EPS);
            const f32x4* gq = (const f32x4*)g_pre + lane;
            u32x2* ho = (u32x2*)(hout + (size_t)row * DM) + lane;
#pragma unroll
            for (int j = 0; j < 8; ++j) { const f32x4 gv = gq[64 * j]; u32x2 w; w.x = cvtpk(xv[j].x * r1 * gv.x, xv[j].y * r1 * gv.y); w.y = cvtpk(xv[j].z * r1 * gv.z, xv[j].w * r1 * gv.w); ho[64 * j] = w; }
        }
    }
}

__device__ __forceinline__ void softmax_pass(const float* S, bf16_t* P, int G, int blk) {
    const int tid = threadIdx.x, lane = tid & 63, wave = tid >> 6;
    const int gw = blk * 8 + wave, NGW = G * 8;
    for (int row = gw; row < MT; row += NGW) {
        const f32x4* sr = (const f32x4*)(S + (size_t)row * 1024) + lane;
        u32x2* pr = (u32x2*)(P + (size_t)row * 1024) + lane;
        f32x4 v[4];
#pragma unroll
        for (int h = 0; h < 4; ++h) v[h] = sr[64 * h];
#pragma unroll
        for (int h = 0; h < 4; ++h) {
            const float mx = wave_max(fmaxf(fmaxf(v[h].x, v[h].y), fmaxf(v[h].z, v[h].w)));
            f32x4 e; e.x = ex2(v[h].x - mx); e.y = ex2(v[h].y - mx); e.z = ex2(v[h].z - mx); e.w = ex2(v[h].w - mx);
            const float inv = 1.0f / wave_sum((e.x + e.y) + (e.z + e.w));
            u32x2 w; w.x = cvtpk(e.x * inv, e.y * inv); w.y = cvtpk(e.z * inv, e.w * inv); pr[64 * h] = w;
        }
    }
}

#ifndef PROBE_DIFF_REPS
#define PROBE_DIFF_REPS 1
#endif
#ifndef PROBE_SB_REPS
#define PROBE_SB_REPS 1
#endif
constexpr int A_KBUF = 16384, A_VBUF = 16384, A_KOFF = 0, A_VOFF = 2 * A_KBUF, A_TAB = A_VOFF + 2 * A_VBUF, A_FLAG = A_TAB + 1024;
#define MFMA32(a, b, c) __builtin_amdgcn_mfma_f32_32x32x16_bf16((a), (b), (c), 0, 0, 0)
#define SCHEDB() __builtin_amdgcn_sched_barrier(0)
__device__ __forceinline__ int crow(int r, int h) { return (r & 3) + 8 * (r >> 2) + 4 * h; }

template <int KD>
__device__ __forceinline__ void tile_dma(const bf16_t* Kg, const bf16_t* Vg, LAS unsigned char* kb, LAS unsigned char* vb, int wid, int lane) {
    if (KD == 128) {
#pragma unroll
        for (int i = 0; i < 2; ++i) {
            const int kc = wid * 2 + i, rho = 4 * kc + (lane >> 4), x = lane & 15, i5 = rho & 31;
            const int key = (rho & 32) + 16 * ((i5 >> 2) & 1) + 8 * (i5 >> 4) + 4 * ((i5 >> 3) & 1) + (i5 & 3);
            const bf16_t* src = Kg + (size_t)key * KD + ((x ^ (rho & 15)) * 8);
            __builtin_amdgcn_global_load_lds((const unsigned*)src, (LAS unsigned*)(kb + kc * 1024), 16, 0, 0);
        }
    } else {
        const int kc = wid, rho = 8 * kc + (lane >> 3), x = lane & 7, i5 = rho & 31;
        const int key = (rho & 32) + 16 * ((i5 >> 2) & 1) + 8 * (i5 >> 4) + 4 * ((i5 >> 3) & 1) + (i5 & 3);
        const bf16_t* src = Kg + (size_t)key * KD + ((x ^ ((rho >> 1) & 7)) * 8);
        __builtin_amdgcn_global_load_lds((const unsigned*)src, (LAS unsigned*)(kb + kc * 1024), 16, 0, 0);
    }
#pragma unroll
    for (int i = 0; i < 2; ++i) {
        const int vc = wid * 2 + i, rho = 8 * vc + (lane >> 3), x = lane & 7;
        const bf16_t* src = Vg + (size_t)rho * 64 + ((x ^ ((rho >> 1) & 7)) * 8);
        __builtin_amdgcn_global_load_lds((const unsigned*)src, (LAS unsigned*)(vb + vc * 1024), 16, 0, 0);
    }
}
__device__ __forceinline__ bf16x8 pack8(const f32x16& s, int o) {
    u32x4 w; w.x = cvtpk(s[o], s[o + 1]); w.y = cvtpk(s[o + 2], s[o + 3]); w.z = cvtpk(s[o + 4], s[o + 5]); w.w = cvtpk(s[o + 6], s[o + 7]);
    return __builtin_bit_cast(bf16x8, w);
}
__device__ __forceinline__ void pv_acc(f32x16 (&O)[4], const f32x16& s0, const f32x16& s1, const LAS unsigned char* vbase, int xv) {
#pragma unroll
    for (int g = 0; g < 4; ++g) {
        const int kbk = g >> 1, s = g & 1;
        const int co = ((4 * kbk + s) ^ xv) << 4;
        bf16x8 vf[4];
#pragma unroll
        for (int db = 0; db < 4; ++db) vf[db] = *(const LAS bf16x8*)(vbase + db * 4096 + co);
        const bf16x8 pf = pack8(kbk ? s1 : s0, 8 * s);
#pragma unroll
        for (int db = 0; db < 4; ++db) O[db] = MFMA32(pf, vf[db], O[db]);
        SCHEDB();
    }
}
template <int NKS, int ROWB>
__device__ __forceinline__ void qk_tile(f32x16& s0, f32x16& s1, const LAS unsigned char* kb, int xk, const bf16x8* qf) {
    bf16x8 a[2][2];
    { const int co = (0 ^ xk) << 4; a[0][0] = *(const LAS bf16x8*)(kb + co); a[0][1] = *(const LAS bf16x8*)(kb + 32 * ROWB + co); }
#pragma unroll
    for (int ks = 0; ks < NKS; ++ks) {
        if (ks + 1 < NKS) { const int co = ((2 * (ks + 1)) ^ xk) << 4; a[(ks + 1) & 1][0] = *(const LAS bf16x8*)(kb + co); a[(ks + 1) & 1][1] = *(const LAS bf16x8*)(kb + 32 * ROWB + co); }
        s0 = MFMA32(a[ks & 1][0], qf[ks], s0); s1 = MFMA32(a[ks & 1][1], qf[ks], s1);
        SCHEDB();
    }
}

__device__ __forceinline__ void smax_update(f32x16& s0, f32x16& s1, float& m, float& l, f32x16 (&O)[4], int hh) {
    float mx = fmaxf(s0[0], s1[0]);
#pragma unroll
    for (int r = 1; r < 16; ++r) mx = fmaxf(mx, fmaxf(s0[r], s1[r]));
    mx = fmaxf(mx, __shfl_xor(mx, 32));
    if (__any(mx > m + 8.0f)) {
        const float mn = fmaxf(m, mx);
        const float alpha = ex2(m - mn);
        l *= alpha; m = mn;
        int hl = hh; asm volatile("" : "+v"(hl));
#pragma unroll
        for (int r = 0; r < 16; ++r) { const float a = __shfl(alpha, crow(r, hl));
#pragma unroll
            for (int db = 0; db < 4; ++db) O[db][r] *= a; }
    }
    float sum = 0.f;
#pragma unroll
    for (int r = 0; r < 16; ++r) { s0[r] = ex2(s0[r] - m); s1[r] = ex2(s1[r] - m); sum += s0[r] + s1[r]; }
    l += sum;
}

#define MX3(a, b, c) __builtin_fmaxf(__builtin_fmaxf((a), (b)), (c))
__device__ __forceinline__ void diff_unit(const Params& p, LAS unsigned char* lds, int b, int h, int qb, float lam) {
    int tid_ = threadIdx.x; asm volatile("" : "+v"(tid_));
    const int tid = tid_, lane = tid & 63, wid = __builtin_amdgcn_readfirstlane(tid >> 6), c = lane & 31, hh = lane >> 5;
    const bf16_t* QK = (const bf16_t*)(p.ws + WS_QK); const bf16_t* VT = (const bf16_t*)(p.ws + WS_VT); bf16_t* AO = (bf16_t*)(p.ws + WS_AO);
    const size_t rowbase = (size_t)b * SEQ;
    const int q0 = qb * 256 + wid * 32, mylast = q0 >> 6, NT = 4 * qb + 4;
    const int xk = ((c >> 1) & 7) ^ hh, xv = ((c >> 1) & 7) ^ (2 * hh);
    LAS float* tab = (LAS float*)(lds + A_TAB);
    if (tid < 256) { const int d = tid - 64, n = d < 0 ? -d : d; int bk = (n < 8) ? n : min(15, 2 + (31 - __clz(n * n))); if (d < 0) bk += 16;
        tab[tid] = (p.rel_bias[bk * 8 + h] - p.rel_bias[15 * 8 + h]) * LOG2E; }
    const bf16_t* Vg0 = VT + ((size_t)h * 512 + (size_t)b * 64) * 8192;
    unsigned* park = (unsigned*)(p.ws + WS_PARK) + ((size_t)(blockIdx.x * 8 + wid) * 32) * 64 + lane;
    const bf16x8 ones = (bf16x8){0x3f80, 0x3f80, 0x3f80, 0x3f80, 0x3f80, 0x3f80, 0x3f80, 0x3f80};
    f32x16 O[4];
#pragma unroll
    for (int mp = 0; mp < 2; ++mp) {
        const bf16_t* Kg0 = (const bf16_t*)(p.ws + WS_KD) + ((size_t)(2 * h + mp) * MT + rowbase) * 64;
        tile_dma<64>(Kg0, Vg0, lds + A_KOFF, lds + A_VOFF, wid, lane);
        const bf16_t* qp = QK + (rowbase + q0 + c) * 4096 + h * 128 + 64 * mp + hh * 8;
        bf16x8 qf[4];
#pragma unroll
        for (int ks = 0; ks < 4; ++ks) qf[ks] = *(const bf16x8*)(qp + 16 * ks);
#pragma unroll
        for (int db = 0; db < 4; ++db) O[db] = (f32x16){};
        f32x16 L = (f32x16){};
        f32x16 negm = (f32x16){};
        float m = 0.f;
        asm volatile("s_waitcnt vmcnt(0)" ::: "memory");
        __syncthreads();
        for (int jt = 0; jt < NT; ++jt) {
            const int cur = jt & 1;
            if (jt + 1 < NT) tile_dma<64>(Kg0 + (size_t)(jt + 1) * 4096, Vg0 + (size_t)(jt + 1) * 8192, lds + A_KOFF + (cur ^ 1) * A_KBUF, lds + A_VOFF + (cur ^ 1) * A_VBUF, wid, lane);
            if (jt <= mylast) {
                const LAS unsigned char* kb = lds + A_KOFF + cur * A_KBUF + c * 128;
                const LAS unsigned char* vb = lds + A_VOFF + cur * A_VBUF + c * 128;
                f32x16 s0, s1;
                {
                    bf16x8 a[2][2];
                    { const int co = (0 ^ xk) << 4; a[0][0] = *(const LAS bf16x8*)(kb + co); a[0][1] = *(const LAS bf16x8*)(kb + 4096 + co); }
#pragma unroll
                    for (int ks = 0; ks < 4; ++ks) {
                        if (ks + 1 < 4) { const int co = ((2 * (ks + 1)) ^ xk) << 4; a[(ks + 1) & 1][0] = *(const LAS bf16x8*)(kb + co); a[(ks + 1) & 1][1] = *(const LAS bf16x8*)(kb + 4096 + co); }
                        if (ks == 0) { s0 = MFMA32(a[0][0], qf[0], negm); s1 = MFMA32(a[0][1], qf[0], negm); }
                        else { s0 = MFMA32(a[ks & 1][0], qf[ks], s0); s1 = MFMA32(a[ks & 1][1], qf[ks], s1); }
                        SCHEDB();
                    }
                }
                if ((q0 - (64 * jt + 63)) < 91) {
                    const int idx0 = (q0 + c) - (64 * jt + 16 * hh) + 64;
#pragma unroll
                    for (int r = 0; r < 16; ++r) { s0[r] += tab[min(idx0 - r, 255)]; s1[r] += tab[min(idx0 - 32 - r, 255)]; if ((r & 3) == 3) SCHEDB(); }
                }
                float mx;
                { float a0 = MX3(s0[0], s0[1], s1[0]), a1 = MX3(s0[2], s0[3], s1[1]); a0 = MX3(a0, s1[2], s1[3]);
#pragma unroll
                  for (int r = 4; r < 16; r += 4) { a0 = MX3(a0, s0[r], s0[r + 1]); a1 = MX3(a1, s0[r + 2], s0[r + 3]); a0 = MX3(a0, s1[r], s1[r + 1]); a1 = MX3(a1, s1[r + 2], s1[r + 3]); }
                  mx = fmaxf(a0, a1); }
                { auto rr = __builtin_amdgcn_permlane32_swap(__float_as_uint(mx), __float_as_uint(mx), false, false); mx = fmaxf(__uint_as_float(rr[0]), __uint_as_float(rr[1])); }
                const bool first = (jt == 0);
                if (first || __any(mx > 8.0f)) {
                    const float dl = first ? mx : fmaxf(mx, 0.f);
                    m += dl;
#pragma unroll
                    for (int r = 0; r < 16; ++r) { s0[r] -= dl; s1[r] -= dl; }
#pragma unroll
                    for (int r = 0; r < 16; ++r) negm[r] = -m;
                    if (!first) {
                        const float alpha = ex2(-dl);
                        int hl = hh; asm volatile("" : "+v"(hl));
#pragma unroll
                        for (int r = 0; r < 16; ++r) { const float a = __shfl(alpha, crow(r, hl)); L[r] *= a;
#pragma unroll
                            for (int db = 0; db < 4; ++db) O[db][r] *= a; }
                    }
                }
#pragma unroll
                for (int r = 0; r < 16; ++r) s0[r] = ex2(s0[r]);
#pragma unroll
                for (int g = 0; g < 4; ++g) {
                    const int co = ((4 * (g >> 1) + (g & 1)) ^ xv) << 4;
                    bf16x8 vf[4];
#pragma unroll
                    for (int db = 0; db < 4; ++db) vf[db] = *(const LAS bf16x8*)(vb + db * 4096 + co);
                    const bf16x8 pf = pack8((g >> 1) ? s1 : s0, 8 * (g & 1));
#pragma unroll
                    for (int db = 0; db < 4; ++db) O[db] = MFMA32(pf, vf[db], O[db]);
                    L = MFMA32(pf, ones, L);
                    if (g < 2) {
#pragma unroll
                        for (int r = 0; r < 8; ++r) s1[8 * g + r] = ex2(s1[8 * g + r]);
                    }
                    SCHEDB();
                }
            }
            asm volatile("s_waitcnt vmcnt(0)" ::: "memory");
            __syncthreads();
        }
#pragma unroll
        for (int r = 0; r < 16; ++r) { const float a = (mp == 0 ? 1.0f : lam) / L[r];
#pragma unroll
            for (int db = 0; db < 4; ++db) O[db][r] *= a; }
        if (mp == 0) {
#pragma unroll
            for (int db = 0; db < 4; ++db)
#pragma unroll
                for (int j = 0; j < 8; ++j) park[(db * 8 + j) * 64] = cvtpk(O[db][2 * j], O[db][2 * j + 1]);
        }
    }
    float gn[4];
#pragma unroll
    for (int db = 0; db < 4; ++db) gn[db] = p.diff_gain[32 * db + c] * 0.8f;
#pragma unroll
    for (int r = 0; r < 16; ++r) {
        const int qr = crow(r, hh);
        float o[4]; float ss = 0.f;
#pragma unroll
        for (int db = 0; db < 4; ++db) { const unsigned w = park[(db * 8 + (r >> 1)) * 64]; o[db] = ((r & 1) ? bf_hi(w) : bf_lo(w)) - O[db][r]; ss += o[db] * o[db]; }
#pragma unroll
        for (int off = 1; off < 32; off <<= 1) ss += __shfl_xor(ss, off);
        const float rs = 1.0f / sqrtf(ss * (1.0f / 128.0f) + EPS);
        bf16_t* op = AO + (rowbase + q0 + qr) * DM + h * 128 + c;
#pragma unroll
        for (int db = 0; db < 4; ++db) op[32 * db] = (bf16_t)(cvtpk(o[db] * rs * gn[db], 0.f) & 0xffffu);
    }
}
#undef MX3

__device__ __forceinline__ void sb_unit(const Params& p, LAS unsigned char* lds, int b, int h, int qb) {
    int tid_ = threadIdx.x; asm volatile("" : "+v"(tid_));
    const int tid = tid_, lane = tid & 63, wid = __builtin_amdgcn_readfirstlane(tid >> 6), c = lane & 31, hh = lane >> 5;
    const bf16_t* QK = (const bf16_t*)(p.ws + WS_QK); const bf16_t* VT = (const bf16_t*)(p.ws + WS_VT); bf16_t* AO = (bf16_t*)(p.ws + WS_AO);
    const size_t rowbase = (size_t)b * SEQ;
    const int q0 = qb * 256 + wid * 32, mylast = q0 >> 6, T0 = 4 * qb + 3;
    const int xk = (c & 15) ^ hh, xv = ((c >> 1) & 7) ^ (2 * hh);
    LAS unsigned* flag = (LAS unsigned*)(lds + A_FLAG);
    const bf16_t* Kg0 = (const bf16_t*)(p.ws + WS_KS) + ((size_t)h * MT + rowbase) * 128;
    const bf16_t* Vg0 = VT + ((size_t)(8 + h) * 512 + (size_t)b * 64) * 8192;
    tile_dma<128>(Kg0 + (size_t)T0 * 8192, Vg0 + (size_t)T0 * 8192, lds + A_KOFF, lds + A_VOFF, wid, lane);
    const bf16_t* qp = QK + (rowbase + q0 + c) * 4096 + 2048 + h * 128 + hh * 8;
    bf16x8 qf[8];
#pragma unroll
    for (int ks = 0; ks < 8; ++ks) qf[ks] = *(const bf16x8*)(qp + 16 * ks);
    f32x16 O[4];
#pragma unroll
    for (int db = 0; db < 4; ++db) O[db] = (f32x16){};
    float carry = 0.f; bool done = false;
    asm volatile("s_waitcnt vmcnt(0)" ::: "memory");
    __syncthreads();
    for (int jt = T0; jt >= 0; --jt) {
        const int cur = (T0 - jt) & 1;
        if (jt > 0) tile_dma<128>(Kg0 + (size_t)(jt - 1) * 8192, Vg0 + (size_t)(jt - 1) * 8192, lds + A_KOFF + (cur ^ 1) * A_KBUF, lds + A_VOFF + (cur ^ 1) * A_VBUF, wid, lane);
        if (jt <= mylast && !done) {
            const LAS unsigned char* kb = lds + A_KOFF + cur * A_KBUF + c * 256;
            const LAS unsigned char* vb = lds + A_VOFF + cur * A_VBUF + c * 128;
            f32x16 s0 = (f32x16){}, s1 = (f32x16){};
            qk_tile<8, 256>(s0, s1, kb, xk, qf);
            const bool diag = (jt == mylast);
            const int lim = (q0 + c) - (64 * jt + 16 * hh);
            float run = 0.f;
#pragma unroll
            for (int r = 15; r >= 0; --r) {
                const float z = s1[r]; const float sp = fmaxf(z, 0.f) + lg2(1.0f + ex2(-fabsf(z)));
                float lk = -sp, lb = z - sp;
                if (diag && !(r + 32 < lim)) { lk = 0.f; lb = -1e30f; }
                s1[r] = lb + run; run += lk;
            }
            const float T1 = run; run = 0.f;
#pragma unroll
            for (int r = 15; r >= 0; --r) {
                const float z = s0[r]; const float sp = fmaxf(z, 0.f) + lg2(1.0f + ex2(-fabsf(z)));
                float lk = -sp, lb = z - sp;
                if (diag && !(r < lim)) { lk = 0.f; lb = -1e30f; }
                s0[r] = lb + run; run += lk;
            }
            const float T0s = run;
            const float T1p = __shfl_xor(T1, 32), T0p = __shfl_xor(T0s, 32);
            const float off1 = carry + (hh ? 0.f : T1p);
            const float off0 = carry + T1 + T1p + (hh ? 0.f : T0p);
#pragma unroll
            for (int r = 0; r < 16; ++r) { s1[r] = ex2(s1[r] + off1); s0[r] = ex2(s0[r] + off0); }
            carry += (T1 + T1p) + (T0s + T0p);
            pv_acc(O, s0, s1, vb, xv);
            done = __all(carry < -60.0f);
        }
        if (lane == 0) flag[cur * 8 + wid] = done ? 1u : 0u;
        asm volatile("s_waitcnt vmcnt(0)" ::: "memory");
        __syncthreads();
        const u32x4 f0 = *(const LAS u32x4*)(flag + cur * 8), f1 = *(const LAS u32x4*)(flag + cur * 8 + 4);
        if ((f0.x & f0.y & f0.z & f0.w & f1.x & f1.y & f1.z & f1.w) != 0u) break;
    }
    float gn[4];
#pragma unroll
    for (int db = 0; db < 4; ++db) gn[db] = p.sb_gain[32 * db + c];
#pragma unroll
    for (int r = 0; r < 16; ++r) {
        const int qr = crow(r, hh);
        float ss = 0.f;
#pragma unroll
        for (int db = 0; db < 4; ++db) ss += O[db][r] * O[db][r];
#pragma unroll
        for (int off = 1; off < 32; off <<= 1) ss += __shfl_xor(ss, off);
        const float rs = 1.0f / sqrtf(ss * (1.0f / 128.0f) + EPS);
        bf16_t* op = AO + (rowbase + q0 + qr) * DM + 1024 + h * 128 + c;
#pragma unroll
        for (int db = 0; db < 4; ++db) op[32 * db] = (bf16_t)(cvtpk(O[db][r] * rs * gn[db], 0.f) & 0xffffu);
    }
    asm volatile("s_waitcnt vmcnt(0)" ::: "memory");
    __syncthreads();
}

__device__ __forceinline__ void attention_phase(const Params& p, LAS unsigned char* lds, int G, int blk) {
    float s1 = 0.f, s2 = 0.f;
    for (int i = 0; i < 64; ++i) { s1 += p.lq1[i] * p.lk1[i]; s2 += p.lq2[i] * p.lk2[i]; }
    const float lam = expf(s1) - expf(s2) + 0.2f;
    const int v = (G % 8 == 0) ? (blk % 8) * (G / 8) + blk / 8 : blk;
    for (int rep = 0; rep < PROBE_DIFF_REPS; ++rep)
    for (int u = v; u < 1024; u += G) {
        const int bh = (u & 255) >> 2, s = u & 3, i = u >> 8;
        const int qb = (i == 0) ? s : (i == 1) ? 7 - s : (i == 2) ? 8 + s : 15 - s;
#ifndef NO_DIFF
        diff_unit(p, lds, bh >> 3, bh & 7, qb, lam);
#endif
    }
    for (int rep = 0; rep < PROBE_SB_REPS; ++rep)
    for (int u = v; u < 1024; u += G) {
        const int bh = (u & 255) >> 2, s = u & 3, i = u >> 8;
        const int qb = (i == 0) ? s : (i == 1) ? 7 - s : (i == 2) ? 8 + s : 15 - s;
#ifndef NO_SB
        sb_unit(p, lds, bh >> 3, bh & 7, qb);
#endif
    }
}

constexpr int LDS_BYTES = 143360;

__global__ void __launch_bounds__(512) fwd_megakernel(Params p) {
    extern __shared__ __attribute__((aligned(16))) unsigned char lds_raw[];
    LAS unsigned char* lds = (LAS unsigned char*)lds_raw;
    cg::grid_group grid = cg::this_grid();
    const int G = gridDim.x, blk = blockIdx.x;
    unsigned char* ws = p.ws;

#ifdef ONLY_GEMM
#define GEMM(gi) do { if (gi == ONLY_GEMM) pg8::gemm_phase<gi>(lds, ws, G, blk); } while (0)
#else
#define GEMM(gi) pg8::gemm_phase<gi>(lds, ws, G, blk)
#endif
    volatile LAS unsigned* xst = (volatile LAS unsigned*)(lds + 131072);
    unsigned* barw = (unsigned*)ws;
    if (threadIdx.x < 2) xst[threadIdx.x] = 0u;
    if (blk == 0) for (int i = threadIdx.x; i < XCD_BAR_WORDS; i += 512) barw[i] = 0u;
    prologue<0>(p, lds, G, blk);
#ifdef PROBE_PRO2
    __syncthreads(); prologue<0>(p, lds, G, blk);
#endif
    grid.sync();
    XcdBarrier xbar = xcd_barrier_post(barw, xst);
    GEMM(0); GEMM(1); GEMM(2);
    if (blk >= G / 2) prologue<1>(p, lds, G, blk);
#ifdef PROBE_G012
    GEMM(0); GEMM(1); GEMM(2);
#endif
    GSYNC();
    attention_phase(p, lds, G, blk); GSYNC();
    GEMM(3); GEMM(4); GEMM(5); GSYNC();
    row_pass<true, false, true>((const bf16_t*)(ws + WS_MIX), p.x, ws + WS_XR, p.g_mix_post, p.g_mem_pre, (bf16_t*)(ws + WS_H), G, blk);
#ifdef PROBE_R12
    row_pass<true, false, true>((const bf16_t*)(ws + WS_MIX), p.x, ws + WS_XR, p.g_mix_post, p.g_mem_pre, (bf16_t*)(ws + WS_H), G, blk);
#endif
    GSYNC();
    GEMM(6); GSYNC();
    GEMM(7); GSYNC();
    row_pass<true, true, true>((const bf16_t*)(ws + WS_MEMO), ws + WS_XR, ws + WS_XR, p.g_mem_post, p.g_ffn_pre, (bf16_t*)(ws + WS_H), G, blk); GSYNC();
    GEMM(8);
#ifdef PROBE_G8
    GEMM(8);
#endif
    GSYNC();
    GEMM(9);
#ifdef PROBE_G9
    GEMM(9);
#endif
    GSYNC();
    row_pass<false, true, false>((const bf16_t*)(ws + WS_FO), ws + WS_XR, p.out, p.g_ffn_post, nullptr, nullptr, G, blk);
#undef GEMM
}

extern "C" void kernel_launch(void* const* d_in, const int* in_sizes, int n_in, void* d_out, int out_size, void* d_ws, size_t ws_size, hipStream_t stream) {
    static int grid_blocks = 0;
    if (grid_blocks == 0) {
        if (n_in != 23 || ws_size < WS_END) { fprintf(stderr, "kernel_launch: unexpected n_in %d / ws %zu\n", n_in, ws_size); grid_blocks = -1; return; }
        int dev = 0, cus = 0, per_cu = 0;
        hipGetDevice(&dev);
        hipDeviceGetAttribute(&cus, hipDeviceAttributeMultiprocessorCount, dev);
        if (hipFuncSetAttribute((const void*)fwd_megakernel, hipFuncAttributeMaxDynamicSharedMemorySize, LDS_BYTES) != hipSuccess) { fprintf(stderr, "kernel_launch: hipFuncSetAttribute failed\n"); }
        if (hipOccupancyMaxActiveBlocksPerMultiprocessor(&per_cu, (const void*)fwd_megakernel, 512, LDS_BYTES) != hipSuccess || per_cu < 1) { fprintf(stderr, "kernel_launch: occupancy query gave %d\n", per_cu); per_cu = 1; }
        (void)hipGetLastError();
        grid_blocks = cus * 1;
        if (grid_blocks > 256) grid_blocks = 256;
    }
    if (grid_blocks < 0) return;
    Params p{};
    const float* const* in = (const float* const*)d_in;
    p.x = in[0]; p.mem = in[1]; p.w_in = in[2]; p.w_out = in[3]; p.rel_bias = in[4];
    p.lq1 = in[5]; p.lk1 = in[6]; p.lq2 = in[7]; p.lk2 = in[8];
    p.diff_gain = in[9]; p.sb_gain = in[10]; p.g_mix_pre = in[11]; p.g_mix_post = in[12];
    p.w_mq = in[13]; p.w_mkv = in[14]; p.w_mo = in[15]; p.g_mem_kv = in[16]; p.g_mem_pre = in[17]; p.g_mem_post = in[18];
    p.w_gu = in[19]; p.w_down = in[20]; p.g_ffn_pre = in[21]; p.g_ffn_post = in[22];
    p.out = (float*)d_out; p.ws = (unsigned char*)d_ws;
    void* args[] = {&p};
    hipError_t e = hipLaunchCooperativeKernel((const void*)fwd_megakernel, dim3(grid_blocks), dim3(512), args, LDS_BYTES, stream);
    if (e != hipSuccess) fprintf(stderr, "cooperative launch failed: %s (grid %d)\n", hipGetErrorString(e), grid_blocks);
}
```
